# Optimizing an MI355X kernel written in HIP

```python
import math
import jax, jax.numpy as jnp
from jax import lax
import numpy as np

D_MODEL = 2048
BATCH = 4
SEQ = 4096
DEPTH = 4

GRID_W = 64
CTX_LEN = 256
N_MIXERS = 3
N_GA = len(range(0, DEPTH, N_MIXERS))
N_RT = len(range(1, DEPTH, N_MIXERS))
N_DF = len(range(2, DEPTH, N_MIXERS))

EPS = 1e-6
NEG_INF = -1e30
ROPE_THETA = 10000.0
BLOCK = 128

GA_HD = 128
GA_HEADS = D_MODEL // GA_HD
GA_KV = GA_HEADS // 4
GA_GROUP = GA_HEADS // GA_KV
WINDOW = 128

RT_HEADS = 8
RT_QK = D_MODEL // RT_HEADS
RT_V = 2 * RT_QK
CHUNK = 128

DF_HD = 128
DF_HEADS = D_MODEL // (2 * DF_HD)

D_FF = 256 * math.ceil(8 * D_MODEL / (3 * 256))
CONV_W = 3

kernel_name = "hybrid_interleaved_dit_prefix_block"


def rms_norm(x, g):
    xf = x.astype(jnp.float32)
    y = xf * lax.rsqrt(jnp.mean(xf * xf, -1, keepdims=True) + EPS)
    return (y * g.astype(jnp.float32)).astype(x.dtype)


def head_group_norm(o, g):
    mu = jnp.mean(o, -1, keepdims=True)
    d = o - mu
    var = jnp.mean(d * d, -1, keepdims=True)
    return d * lax.rsqrt(var + EPS) * g.astype(jnp.float32).reshape(o.shape[2:])


def modulate(h, shift, scale):
    return h * (1 + scale) + shift


def adaln(cond, w, b):
    m = jax.nn.silu(cond) @ w + b
    return jnp.split(m, 6, -1)


def rope(x, cos, sin):
    half = x.shape[-1] // 2
    xf = x.astype(jnp.float32)
    x1, x2 = xf[..., :half], xf[..., half:]
    return jnp.concatenate([x1 * cos - x2 * sin, x1 * sin + x2 * cos], -1).astype(x.dtype)


def axial_rope_tables(rows_count, head_dim):
    rows = jnp.repeat(jnp.arange(rows_count), GRID_W).astype(jnp.float32)
    cols = jnp.tile(jnp.arange(GRID_W), rows_count).astype(jnp.float32)
    n_freq = head_dim // 4
    inv = ROPE_THETA ** (-jnp.arange(n_freq, dtype=jnp.float32) / n_freq)
    ang = jnp.concatenate([rows[:, None] * inv, cols[:, None] * inv], -1)
    return jnp.cos(ang), jnp.sin(ang)


def linear_rope_tables(n_tokens, head_dim):
    half = head_dim // 2
    inv = ROPE_THETA ** (-jnp.arange(half, dtype=jnp.float32) / half)
    ang = jnp.arange(n_tokens, dtype=jnp.float32)[:, None] * inv
    return jnp.cos(ang), jnp.sin(ang)


def joint_softmax(parts, sink=None):
    m = parts[0].max(-1, keepdims=True)
    for p in parts[1:]:
        m = jnp.maximum(m, p.max(-1, keepdims=True))
    if sink is not None:
        m = jnp.maximum(m, sink)
    es = [jnp.exp(p - m) for p in parts]
    den = sum(e.sum(-1, keepdims=True) for e in es)
    if sink is not None:
        den = den + jnp.exp(sink - m)
    return [e / den for e in es]


def windowed_gqa_mixer(h_lat, h_ctx, wqkv, sink, qk_g, wo, cos, sin, need_ctx):
    B, S, _ = h_lat.shape
    G = GA_GROUP
    scale = GA_HD ** -0.5

    def project(h):
        n = h.shape[1]
        q, k, v = jnp.split(h @ wqkv, [GA_HEADS * GA_HD, (GA_HEADS + GA_KV) * GA_HD], -1)
        q = rms_norm(q.reshape(B, n, GA_KV, G, GA_HD), qk_g[0]) * scale
        k = rms_norm(k.reshape(B, n, GA_KV, GA_HD), qk_g[1])
        return q, k, v.reshape(B, n, GA_KV, GA_HD)

    qc, kc, vc = project(h_ctx)
    ql, kl, vl = project(h_lat)
    ql = rope(ql, cos[:, None, None], sin[:, None, None])
    kl = rope(kl, cos[:, None], sin[:, None])
    sink_b = sink.astype(jnp.float32).reshape(GA_KV, G)[:, :, None, None]

    nb = S // BLOCK
    qb = ql.reshape(B, nb, BLOCK, GA_KV, G, GA_HD)

    def band(t):
        tp = jnp.pad(t, ((0, 0), (BLOCK, BLOCK), (0, 0), (0, 0))).reshape(B, nb + 2, BLOCK, *t.shape[2:])
        return jnp.concatenate([tp[:, :-2], tp[:, 1:-1], tp[:, 2:]], axis=2)

    kw, vw = band(kl), band(vl)
    qpos = jnp.arange(S).reshape(nb, BLOCK)[:, :, None]
    kpos = (jnp.arange(nb)[:, None] * BLOCK - BLOCK + jnp.arange(3 * BLOCK)[None, :])[:, None, :]
    mask = (jnp.abs(kpos - qpos) <= WINDOW) & (kpos >= 0) & (kpos < S)
    s_loc = jnp.einsum("bcingd,bcjnd->bcngij", qb, kw).astype(jnp.float32)
    s_loc = jnp.where(mask[None, :, None, None], s_loc, NEG_INF)
    s_ctx = jnp.einsum("bcingd,bjnd->bcngij", qb, kc).astype(jnp.float32)
    p_loc, p_ctx = joint_softmax([s_loc, s_ctx], sink_b)
    o = (jnp.einsum("bcngij,bcjnd->bcingd", p_loc.astype(vw.dtype), vw)
         + jnp.einsum("bcngij,bjnd->bcingd", p_ctx.astype(vc.dtype), vc))
    y_lat = o.reshape(B, S, GA_HEADS * GA_HD) @ wo

    y_ctx = None
    if need_ctx:
        s = jnp.einsum("bingd,bjnd->bngij", qc, kc).astype(jnp.float32)
        (p,) = joint_softmax([s], sink_b)
        oc = jnp.einsum("bngij,bjnd->bingd", p.astype(vc.dtype), vc)
        y_ctx = oc.reshape(B, h_ctx.shape[1], GA_HEADS * GA_HD) @ wo
    return y_lat, y_ctx


def retention_scan(q, k, v, log_gamma, state0):
    B, N, H, dk = q.shape
    dv = v.shape[-1]
    nc = N // CHUNK
    pos = jnp.arange(CHUNK, dtype=jnp.float32)
    rel = pos[:, None] - pos[None, :]
    lg = log_gamma.astype(jnp.float32)
    decay_mask = jnp.where(rel >= 0, jnp.exp(lg[:, None, None] * jnp.maximum(rel, 0.0)), 0.0)
    q_decay = jnp.exp(lg[:, None] * (pos + 1))[:, :, None]
    k_decay = jnp.exp(lg[:, None] * (CHUNK - 1 - pos))[:, :, None]
    chunk_decay = jnp.exp(lg * CHUNK)[:, None, None]

    def to_chunks(t):
        return t.reshape(B, nc, CHUNK, H, t.shape[-1]).transpose(1, 0, 3, 2, 4)

    def step(state, inp):
        qi, ki, vi = inp
        inner = jnp.einsum("bhid,bhjd->bhij", qi, ki) * decay_mask
        o = (jnp.einsum("bhij,bhje->bhie", inner, vi)
             + jnp.einsum("bhid,bhde->bhie", qi, state) * q_decay)
        state = state * chunk_decay + jnp.einsum("bhjd,bhje->bhde", ki * k_decay, vi)
        return state, o

    state, o = lax.scan(step, state0, (to_chunks(q), to_chunks(k), to_chunks(v)))
    return o.transpose(1, 0, 3, 2, 4).reshape(B, N, H, dv), state


def retention_mixer(h_lat, h_ctx, w_in, decay_logit, gn_g, wo, cos, sin, need_ctx):
    B, S, _ = h_lat.shape
    QK, V = RT_HEADS * RT_QK, RT_HEADS * RT_V

    def project(h):
        n = h.shape[1]
        q, k, v, gf, gb = jnp.split(h @ w_in, [QK, 2 * QK, 2 * QK + V, 2 * QK + 2 * V], -1)
        q = q.reshape(B, n, RT_HEADS, RT_QK) * (RT_QK ** -0.5)
        return q, k.reshape(B, n, RT_HEADS, RT_QK), v.reshape(B, n, RT_HEADS, RT_V), gf, gb

    log_gamma = jax.nn.log_sigmoid(decay_logit.astype(jnp.float32))
    qc, kc, vc, gfc, gbc = project(h_ctx)
    ql, kl, vl, gfl, gbl = project(h_lat)
    ql = rope(ql, cos[:, None], sin[:, None])
    kl = rope(kl, cos[:, None], sin[:, None])
    flip = lambda t: jnp.flip(t, 1)
    zero = jnp.zeros((B, RT_HEADS, RT_QK, RT_V), jnp.float32)

    oc_f, st_f = retention_scan(qc, kc, vc, log_gamma[0], zero)
    oc_b, st_b = retention_scan(flip(qc), flip(kc), flip(vc), log_gamma[1], zero)
    ol_f, _ = retention_scan(ql, kl, vl, log_gamma[0], st_f)
    ol_b, _ = retention_scan(flip(ql), flip(kl), flip(vl), log_gamma[1], st_b)

    def combine(of, ob, gf, gb):
        n = of.shape[1]
        yf = head_group_norm(of, gn_g[0]).reshape(B, n, V).astype(gf.dtype)
        yb = head_group_norm(ob, gn_g[1]).reshape(B, n, V).astype(gb.dtype)
        return (jax.nn.silu(gf) * yf + jax.nn.silu(gb) * yb) @ wo

    y_lat = combine(ol_f, flip(ol_b), gfl, gbl)
    y_ctx = combine(oc_f, flip(oc_b), gfc, gbc) if need_ctx else None
    return y_lat, y_ctx


def diff_attention_mixer(h_lat, h_ctx, wqkv, lam, qk_g, subln_g, wo, cos, sin, lambda_init, need_ctx):
    B, S, _ = h_lat.shape
    scale = DF_HD ** -0.5

    def project(h):
        n = h.shape[1]
        q, k, v = jnp.split(h @ wqkv, [2 * DF_HEADS * DF_HD, 4 * DF_HEADS * DF_HD], -1)
        q = rms_norm(q.reshape(B, n, DF_HEADS, 2, DF_HD), qk_g[0]) * scale
        k = rms_norm(k.reshape(B, n, DF_HEADS, 2, DF_HD), qk_g[1])
        return q, k, v.reshape(B, n, DF_HEADS, 2 * DF_HD)

    lam_f = lam.astype(jnp.float32)
    lmbda = jnp.exp(jnp.sum(lam_f[0] * lam_f[1])) - jnp.exp(jnp.sum(lam_f[2] * lam_f[3])) + lambda_init

    def attend(q, k_parts, v_parts):
        s = [jnp.einsum("bihrd,bjhrd->bhrij", q, kp).astype(jnp.float32) for kp in k_parts]
        probs = joint_softmax(s)
        return sum(jnp.einsum("bhij,bjhe->bihe", (p[:, :, 0] - lmbda * p[:, :, 1]).astype(vp.dtype), vp)
                   for p, vp in zip(probs, v_parts))

    def finish(o):
        o = rms_norm(o, subln_g) * (1.0 - lambda_init)
        return o.reshape(B, o.shape[1], DF_HEADS * 2 * DF_HD) @ wo

    qc, kc, vc = project(h_ctx)
    ql, kl, vl = project(h_lat)
    ql = rope(ql, cos[:, None, None], sin[:, None, None])
    kl = rope(kl, cos[:, None, None], sin[:, None, None])

    nb = S // BLOCK
    qb = ql.reshape(B, nb, BLOCK, DF_HEADS, 2, DF_HD).transpose(1, 0, 2, 3, 4, 5)
    o = lax.map(lambda qblk: attend(qblk, [kl, kc], [vl, vc]), qb)
    y_lat = finish(o.transpose(1, 0, 2, 3, 4).reshape(B, S, DF_HEADS, 2 * DF_HD))
    y_ctx = finish(attend(qc, [kc], [vc])) if need_ctx else None
    return y_lat, y_ctx


def conv_ffn(h, w_in, conv_w, conv_b, w_out):
    u = h @ w_in
    n = u.shape[1]
    pad = CONV_W // 2
    up = jnp.pad(u, ((0, 0), (pad, pad), (0, 0)))
    u = conv_b + sum(up[:, t:t + n] * conv_w[t] for t in range(CONV_W))
    a, b = jnp.split(u, 2, -1)
    return (jax.nn.silu(a) * b) @ w_out


def setup_inputs(seed: int = 0) -> dict:
    key = jax.random.key(seed)
    ks = iter(jax.random.split(key, 32))
    f32 = jnp.float32
    D = D_MODEL

    def nrm(shape, s):
        return jax.random.normal(next(ks), shape, f32) * s

    gamma0 = 1.0 - 2.0 ** (-5.0 - np.arange(RT_HEADS))
    decay_init = jnp.asarray(np.log(gamma0 / (1.0 - gamma0)), f32)
    ga_q = GA_HEADS * GA_HD
    return {
        "x": nrm((BATCH, SEQ, D), 1.0),
        "c": nrm((BATCH, D), 1.0),
        "ctx": nrm((BATCH, CTX_LEN, D), 1.0),
        "c_ctx": nrm((D,), 1.0),
        "mod_w": nrm((DEPTH, D, 6 * D), 0.5 * D ** -0.5),
        "mod_b": nrm((DEPTH, 6 * D), 0.02),
        "norm_g": 1.0 + nrm((DEPTH, 2, D), 0.02),
        "ffn_w_in": nrm((DEPTH, D, 2 * D_FF), D ** -0.5),
        "ffn_conv_w": nrm((DEPTH, CONV_W, 2 * D_FF), CONV_W ** -0.5),
        "ffn_conv_b": nrm((DEPTH, 2 * D_FF), 0.02),
        "ffn_w_out": nrm((DEPTH, D_FF, D), D_FF ** -0.5),
        "ga_wqkv": nrm((N_GA, D, ga_q + 2 * GA_KV * GA_HD), D ** -0.5),
        "ga_sink": nrm((N_GA, GA_HEADS), 0.5),
        "ga_qk_norm": 1.0 + nrm((N_GA, 2, GA_HD), 0.02),
        "ga_wo": nrm((N_GA, ga_q, D), ga_q ** -0.5),
        "rt_w_in": nrm((N_RT, D, 2 * RT_HEADS * RT_QK + 3 * RT_HEADS * RT_V), D ** -0.5),
        "rt_decay": decay_init[None, None, :] + nrm((N_RT, 2, RT_HEADS), 0.1),
        "rt_gn": 1.0 + nrm((N_RT, 2, RT_HEADS * RT_V), 0.02),
        "rt_wo": nrm((N_RT, RT_HEADS * RT_V, D), (RT_HEADS * RT_V) ** -0.5),
        "df_wqkv": nrm((N_DF, D, 6 * DF_HEADS * DF_HD), D ** -0.5),
        "df_lambda": nrm((N_DF, 4, DF_HD), 0.1),
        "df_qk_norm": 1.0 + nrm((N_DF, 2, DF_HD), 0.02),
        "df_subln": 1.0 + nrm((N_DF, 2 * DF_HD), 0.02),
        "df_wo": nrm((N_DF, 2 * DF_HEADS * DF_HD, D), (2 * DF_HEADS * DF_HD) ** -0.5),
    }


def reference(x, c, ctx, c_ctx, mod_w, mod_b, norm_g, ffn_w_in, ffn_conv_w, ffn_conv_b, ffn_w_out,
              ga_wqkv, ga_sink, ga_qk_norm, ga_wo, rt_w_in, rt_decay, rt_gn, rt_wo,
              df_wqkv, df_lambda, df_qk_norm, df_subln, df_wo):
    n_lat = x.shape[1]
    ROWS = n_lat // GRID_W
    ga_cos, ga_sin = axial_rope_tables(ROWS, GA_HD)
    df_cos, df_sin = axial_rope_tables(ROWS, DF_HD)
    rt_cos, rt_sin = linear_rope_tables(n_lat, RT_QK)

    h_lat, h_ctx = x, ctx
    for i in range(DEPTH):
        need_ctx = i < DEPTH - 1
        kind, j = i % N_MIXERS, i // N_MIXERS
        m_lat = [m[:, None, :] for m in adaln(c, mod_w[i], mod_b[i])]
        m_ctx = adaln(c_ctx, mod_w[i], mod_b[i])
        a_lat = modulate(rms_norm(h_lat, norm_g[i, 0]), m_lat[0], m_lat[1])
        a_ctx = modulate(rms_norm(h_ctx, norm_g[i, 0]), m_ctx[0], m_ctx[1])
        if kind == 0:
            y_lat, y_ctx = windowed_gqa_mixer(a_lat, a_ctx, ga_wqkv[j], ga_sink[j], ga_qk_norm[j], ga_wo[j],
                                              ga_cos, ga_sin, need_ctx)
        elif kind == 1:
            y_lat, y_ctx = retention_mixer(a_lat, a_ctx, rt_w_in[j], rt_decay[j], rt_gn[j], rt_wo[j],
                                           rt_cos, rt_sin, need_ctx)
        else:
            y_lat, y_ctx = diff_attention_mixer(a_lat, a_ctx, df_wqkv[j], df_lambda[j], df_qk_norm[j],
                                                df_subln[j], df_wo[j], df_cos, df_sin,
                                                0.8 - 0.6 * math.exp(-0.3 * i), need_ctx)
        h_lat = h_lat + m_lat[2] * y_lat
        f_lat = modulate(rms_norm(h_lat, norm_g[i, 1]), m_lat[3], m_lat[4])
        h_lat = h_lat + m_lat[5] * conv_ffn(f_lat, ffn_w_in[i], ffn_conv_w[i], ffn_conv_b[i], ffn_w_out[i])
        if need_ctx:
            h_ctx = h_ctx + m_ctx[2] * y_ctx
            f_ctx = modulate(rms_norm(h_ctx, norm_g[i, 1]), m_ctx[3], m_ctx[4])
            h_ctx = h_ctx + m_ctx[5] * conv_ffn(f_ctx, ffn_w_in[i], ffn_conv_w[i], ffn_conv_b[i], ffn_w_out[i])
    return h_lat
```

```cpp
#include <hip/hip_runtime.h>
#include <hip/hip_bf16.h>
#include <cstdio>
#include <cstdint>
namespace pg8 {
#define PG8_LAS __attribute__((address_space(3)))
typedef unsigned short bf16_t;
typedef short bf16x8 __attribute__((ext_vector_type(8)));
typedef float f32x4 __attribute__((ext_vector_type(4)));
typedef unsigned u32x4 __attribute__((ext_vector_type(4)));
__device__ __forceinline__ int tid_of(int wave) { int t = (wave << 6) | (int)__builtin_amdgcn_mbcnt_hi(~0u, __builtin_amdgcn_mbcnt_lo(~0u, 0u)); asm volatile("" : "+v"(t)); return t; }
constexpr int BM = 256, BK = 64, HALF = 128, HTB = HALF * BK * 2  , STAGE_BYTES = 8 * HTB, NXCD = 8, WGM = 4;

__host__ __device__ __forceinline__ int lds_byte(int r, int c) { const int st = (r >> 4) * 2 + (c >> 5), rr = r & 15, cc = c & 31, ob = rr * 64 + cc * 2; return st * 1024 + (ob ^ (((ob >> 9) & 1) << 5)); }
__host__ __device__ __forceinline__ void stage_rc(int b, int& R, int& C) { const int st = b / 1024, sb = b % 1024, swz = sb ^ (((sb >> 9) & 1) << 5); R = (st >> 1) * 16 + swz / 64; C = (st & 1) * 32 + (swz % 64) / 2; }
__host__ __device__ __forceinline__ int perm32(int rho) { const int n = rho >> 4, i = rho & 15; return 8 * (i >> 2) + 4 * n + (i & 3); }

struct Unit { int pm, pn, k0, nt, aux; };
struct Gemm { const bf16_t* A; const bf16_t* Bt; int M, N, K; };
struct StaticOrder {
    int nM, nN, nwg, G, c, lat_only, ntk, split;
    __host__ __device__ void init(int nM_, int N, int K, int G_, int c_, int lat_only_, int split_) { nM = nM_; nN = N / BM; nwg = nM * nN; G = G_; c = c_; lat_only = lat_only_; ntk = K / BK; split = split_; }
    __host__ __device__ int kslice(int ks) const { return 2 * ((ks * (ntk / 2)) / 8); }
    __host__ __device__ bool next(int i, Unit& u) const {
        const long L = (long)i * G + c;
        if (L >= nwg) {
            if (!split || L >= nwg + 256) return false;
            const int s = (int)(L - nwg), ks = s & 7; u.pm = (s >> 6) * 17; u.pn = (s >> 3) & 7; const int t0 = kslice(ks), t1 = kslice(ks + 1);
            u.k0 = t0 * BK; u.nt = t1 - t0; u.aux = ks; return true;
        }
        u.k0 = 0; u.nt = ntk; u.aux = -1;
        int wgid = (int)L; { const int q = nwg / NXCD, r = nwg % NXCD, xcd = wgid % NXCD, off = wgid / NXCD; wgid = (xcd < r ? xcd * (q + 1) : r * (q + 1) + (xcd - r) * q) + off; }
        const int nig = WGM * nN, gid = wgid / nig, fm = gid * WGM, gsz = (nM - fm) < WGM ? (nM - fm) : WGM;
        int pm = fm + ((wgid % nig) % gsz); u.pn = (wgid % nig) / gsz;
        if (lat_only) pm = (pm >> 4) * 17 + 1 + (pm & 15);
        u.pm = pm; return true;
    }
    __device__ __forceinline__ void a_ready(const Unit&) const {}
    __device__ __forceinline__ void done(const Unit&) const {}
};

__device__ __forceinline__ unsigned cvt_pk_bf16(float lo, float hi) { unsigned r; asm volatile("v_cvt_pk_bf16_f32 %0, %1, %2" : "=v"(r) : "v"(lo), "v"(hi)); return r; }
typedef _Float16 f16x2_t __attribute__((ext_vector_type(2)));
__device__ __forceinline__ unsigned pk2h(float lo, float hi) { f16x2_t v = {(_Float16)lo, (_Float16)hi}; return __builtin_bit_cast(unsigned, v); }
__device__ __forceinline__ float h_lo(unsigned w) { return (float)__builtin_bit_cast(f16x2_t, w).x; }
__device__ __forceinline__ float h_hi(unsigned w) { return (float)__builtin_bit_cast(f16x2_t, w).y; }

__device__ __forceinline__ float dpp_prev_lane(float x) { return __builtin_bit_cast(float, __builtin_amdgcn_update_dpp(0, __builtin_bit_cast(int, x), 0x111, 0xf, 0xf, true)); }
__device__ __forceinline__ float dpp_next_lane(float x) { return __builtin_bit_cast(float, __builtin_amdgcn_update_dpp(0, __builtin_bit_cast(int, x), 0x101, 0xf, 0xf, true)); }
struct EpiConvGate {
    static constexpr bool PERM = true, AFTER_DRAIN = false, AROWPERM = true;
    bf16_t* G; bf16_t* EDGE; const float* cw; const float* cb;
    __device__ __forceinline__ void operator()(const f32x4 (&acc)[2][2][4][2], const Unit& u, int wr, int wc, int fr, int fq) const {
        const int row0 = u.pm * BM + wr * 64 + 4 * fr; const int ch0 = u.pn * HALF + wc * 32 + 8 * fq;
        typedef unsigned u32x2 __attribute__((ext_vector_type(2)));
#pragma unroll
        for (int ai = 0; ai < 2; ++ai) {
            u32x2 wlo[4];
#pragma unroll
            for (int n = 0; n < 2; ++n) {
                f32x4 wa[3], wb[3];
#pragma unroll
                for (int t = 0; t < 3; ++t) { wa[t] = *(const f32x4*)(cw + t * 11264 + ch0 + 4 * n); wb[t] = *(const f32x4*)(cw + t * 11264 + 5632 + ch0 + 4 * n); }
                const f32x4 ba = *(const f32x4*)(cb + ch0 + 4 * n), bb = *(const f32x4*)(cb + 5632 + ch0 + 4 * n);
                f32x4 ap, an, bp, bn;
#pragma unroll
                for (int e2 = 0; e2 < 4; ++e2) { ap[e2] = dpp_prev_lane(acc[ai][0][3][n][e2]); an[e2] = dpp_next_lane(acc[ai][0][0][n][e2]); bp[e2] = dpp_prev_lane(acc[ai][1][3][n][e2]); bn[e2] = dpp_next_lane(acc[ai][1][0][n][e2]); }
#pragma unroll
                for (int m = 0; m < 4; ++m) {
                    const f32x4 a0 = m == 0 ? ap : acc[ai][0][m == 0 ? 0 : m - 1][n], a1 = acc[ai][0][m][n], a2 = m == 3 ? an : acc[ai][0][m == 3 ? 3 : m + 1][n];
                    const f32x4 b0 = m == 0 ? bp : acc[ai][1][m - 1 < 0 ? 0 : m - 1][n], b1 = acc[ai][1][m][n], b2 = m == 3 ? bn : acc[ai][1][m == 3 ? 3 : m + 1][n];
                    const f32x4 va = ba + wa[0] * a0 + wa[1] * a1 + wa[2] * a2, vb = bb + wb[0] * b0 + wb[1] * b1 + wb[2] * b2;
                    float gq[4];
#pragma unroll
                    for (int e2 = 0; e2 < 4; ++e2) gq[e2] = va[e2] * __builtin_amdgcn_rcpf(1.f + __builtin_amdgcn_exp2f(-1.4426950408889634f * va[e2])) * vb[e2];
                    u32x2 w; w.x = cvt_pk_bf16(gq[0], gq[1]); w.y = cvt_pk_bf16(gq[2], gq[3]);
                    if (n == 0) wlo[m] = w;
                    else { u32x4 w4; w4.x = wlo[m].x; w4.y = wlo[m].y; w4.z = w.x; w4.w = w.y; *(u32x4*)(G + (size_t)(row0 + ai * HALF + m) * 5632 + ch0) = w4; } }
            }
        }
#pragma unroll
        for (int ai = 0; ai < 2; ++ai) {
            if (fr == 0 || fr == 15) {
                const int run = u.pm * 4 + ai * 2 + wr; const int m0 = fr == 0 ? 0 : 2;
#pragma unroll
                for (int mm = 0; mm < 2; ++mm) { const int m = m0 + mm; bf16_t* ep = EDGE + ((size_t)run * 4 + m) * 11264 + ch0;
#pragma unroll
                    for (int bj = 0; bj < 2; ++bj) { const f32x4 v0 = fr == 0 ? acc[ai][bj][mm][0] : acc[ai][bj][2 + mm][0], v1 = fr == 0 ? acc[ai][bj][mm][1] : acc[ai][bj][2 + mm][1];
                        u32x4 w; w.x = cvt_pk_bf16(v0[0], v0[1]); w.y = cvt_pk_bf16(v0[2], v0[3]); w.z = cvt_pk_bf16(v1[0], v1[1]); w.w = cvt_pk_bf16(v1[2], v1[3]);
                        *(u32x4*)(ep + bj * 5632) = w; } }
            }
        }
    }
};
struct EpiQK {
    static constexpr bool PERM = true, AFTER_DRAIN = false, AROWPERM = false;
    bf16_t* O; int ldc; int nq, nk;
    const float* gq; const float* gk;
    const float* rope;
    float qscale; PG8_LAS float* xch;
    __device__ __forceinline__ void operator()(const f32x4 (&acc)[2][2][4][2], const Unit& u, int wr, int wc, int fr, int fq) const {
        const int row0 = u.pm * BM + wr * 64 + fr; const int col0 = u.pn * BM + wc * 32 + 8 * fq;
        if (u.pn >= nq + nk) {
#pragma unroll
            for (int ai = 0; ai < 2; ++ai)
#pragma unroll
                for (int m = 0; m < 4; ++m) { bf16_t* rowp = O + (size_t)(row0 + ai * HALF + m * 16) * ldc + col0;
#pragma unroll
                    for (int bj = 0; bj < 2; ++bj) { const f32x4 v0 = acc[ai][bj][m][0], v1 = acc[ai][bj][m][1];
                        u32x4 w; w.x = cvt_pk_bf16(v0[0], v0[1]); w.y = cvt_pk_bf16(v0[2], v0[3]); w.z = cvt_pk_bf16(v1[0], v1[1]); w.w = cvt_pk_bf16(v1[2], v1[3]);
                        *(u32x4*)(rowp + bj * HALF) = w; } }
            return;
        }
        const bool isq = u.pn < nq;
#pragma unroll
        for (int ai = 0; ai < 2; ++ai)
#pragma unroll
            for (int m = 0; m < 4; ++m)
#pragma unroll
                for (int bj = 0; bj < 2; ++bj) { const f32x4 v0 = acc[ai][bj][m][0], v1 = acc[ai][bj][m][1];
                    float s = (v0[0] * v0[0] + v0[1] * v0[1]) + (v0[2] * v0[2] + v0[3] * v0[3]) + (v1[0] * v1[0] + v1[1] * v1[1]) + (v1[2] * v1[2] + v1[3] * v1[3]);
                    { auto r_ = __builtin_amdgcn_permlane16_swap(__float_as_uint(s), __float_as_uint(s), false, false); s = __uint_as_float(r_[0]) + __uint_as_float(r_[1]); }
                    { auto r_ = __builtin_amdgcn_permlane32_swap(__float_as_uint(s), __float_as_uint(s), false, false); s = __uint_as_float(r_[0]) + __uint_as_float(r_[1]); }
                    if (fq == 0) xch[(bj * 256 + ai * HALF + wr * 64 + m * 16 + fr) * 4 + wc] = s; }
        asm volatile("s_waitcnt lgkmcnt(0)" ::: "memory"); __builtin_amdgcn_s_barrier(); asm volatile("" ::: "memory");
        const int d0 = 16 * wc + 4 * fq; const float* gp = isq ? gq : gk;
        const f32x4 g1 = *(const f32x4*)(gp + d0), g2 = *(const f32x4*)(gp + 64 + d0);
        const int jt = u.pm % 17; const bool lat = jt != 0; const int t0 = (jt - 1) * 256 + wr * 64 + fr;
#pragma unroll
        for (int ai = 0; ai < 2; ++ai)
#pragma unroll
            for (int m = 0; m < 4; ++m) { const int rl = ai * HALF + wr * 64 + m * 16 + fr; bf16_t* rowp = O + (size_t)(row0 + ai * HALF + m * 16) * ldc + col0;
                f32x4 cs = (f32x4){1.f, 1.f, 1.f, 1.f}, sn = (f32x4){0.f, 0.f, 0.f, 0.f};
                if (lat && rope != nullptr) { const float* rp = rope + (size_t)(t0 + ai * HALF + m * 16) * 128 + d0; cs = *(const f32x4*)rp; sn = *(const f32x4*)(rp + 64); }
#pragma unroll
                for (int bj = 0; bj < 2; ++bj) { const f32x4 p = *(const PG8_LAS f32x4*)(xch + (bj * 256 + rl) * 4);
                    const float r = __builtin_amdgcn_rsqf(((p[0] + p[1]) + (p[2] + p[3])) * (1.f / 128.f) + 1e-6f) * (isq ? qscale : 1.f);
                    const f32x4 v0 = acc[ai][bj][m][0], v1 = acc[ai][bj][m][1];
                    const float a0 = v0[0] * r * g1[0], b0 = v0[1] * r * g2[0], a1 = v0[2] * r * g1[1], b1 = v0[3] * r * g2[1];
                    const float a2 = v1[0] * r * g1[2], b2 = v1[1] * r * g2[2], a3 = v1[2] * r * g1[3], b3 = v1[3] * r * g2[3];
                    u32x4 w;
                    w.x = cvt_pk_bf16(a0 * cs[0] - b0 * sn[0], a0 * sn[0] + b0 * cs[0]); w.y = cvt_pk_bf16(a1 * cs[1] - b1 * sn[1], a1 * sn[1] + b1 * cs[1]);
                    w.z = cvt_pk_bf16(a2 * cs[2] - b2 * sn[2], a2 * sn[2] + b2 * cs[2]); w.w = cvt_pk_bf16(a3 * cs[3] - b3 * sn[3], a3 * sn[3] + b3 * cs[3]);
                    *(u32x4*)(rowp + bj * HALF) = w; } }
    }
};
struct EpiRT {
    static constexpr bool PERM = true, AFTER_DRAIN = false, AROWPERM = false;
    bf16_t* O; int ldc; const float* rope;   bf16_t* KB; const float* decay;
    __device__ __forceinline__ void operator()(const f32x4 (&acc)[2][2][4][2], const Unit& u, int wr, int wc, int fr, int fq) const {
        const int row0 = u.pm * BM + wr * 64 + fr; const int col0 = u.pn * BM + wc * 32 + 8 * fq;
        if (u.pn >= 16) {
#pragma unroll
            for (int ai = 0; ai < 2; ++ai)
#pragma unroll
                for (int m = 0; m < 4; ++m) { bf16_t* rowp = O + (size_t)(row0 + ai * HALF + m * 16) * ldc + col0;
#pragma unroll
                    for (int bj = 0; bj < 2; ++bj) { const f32x4 v0 = acc[ai][bj][m][0], v1 = acc[ai][bj][m][1];
                        u32x4 w; w.x = cvt_pk_bf16(v0[0], v0[1]); w.y = cvt_pk_bf16(v0[2], v0[3]); w.z = cvt_pk_bf16(v1[0], v1[1]); w.w = cvt_pk_bf16(v1[2], v1[3]);
                        __builtin_nontemporal_store(w, (u32x4*)(rowp + bj * HALF)); } }
            return;
        }
        const bool isq = u.pn < 8; const int head = u.pn & 7;
        const float lgf = -__builtin_log2f(1.f + __builtin_expf(-decay[head])), lgb = -__builtin_log2f(1.f + __builtin_expf(-decay[8 + head]));
        const int jt = u.pm % 17; const bool lat = jt != 0; const int t0 = (jt - 1) * 256 + wr * 64 + fr;
        const int dbase = 16 * wc + 4 * fq;
#pragma unroll
        for (int ai = 0; ai < 2; ++ai)
#pragma unroll
            for (int m = 0; m < 4; ++m) { const int row = row0 + ai * HALF + m * 16; const int jc = row & 127;
                bf16_t* rowp = O + (size_t)row * ldc + col0; bf16_t* kbp = KB + (size_t)row * 2048 + head * 256 + wc * 32 + 8 * fq;
                const float s1 = isq ? 0.0625f : __builtin_amdgcn_exp2f(lgf * (float)(127 - jc)), s2 = __builtin_amdgcn_exp2f(lgb * (float)jc);
#pragma unroll
                for (int bj = 0; bj < 2; ++bj) {
                    f32x4 cs = (f32x4){1.f, 1.f, 1.f, 1.f}, sn = (f32x4){0.f, 0.f, 0.f, 0.f};
                    if (lat) { const float* rp = rope + (size_t)(t0 + ai * HALF + m * 16) * 256 + 64 * bj + dbase; cs = *(const f32x4*)rp; sn = *(const f32x4*)(rp + 128); }
                    const f32x4 v0 = acc[ai][bj][m][0], v1 = acc[ai][bj][m][1];
                    const float x0 = v0[0] * cs[0] - v0[1] * sn[0], y0 = v0[0] * sn[0] + v0[1] * cs[0], x1 = v0[2] * cs[1] - v0[3] * sn[1], y1 = v0[2] * sn[1] + v0[3] * cs[1];
                    const float x2 = v1[0] * cs[2] - v1[1] * sn[2], y2 = v1[0] * sn[2] + v1[1] * cs[2], x3 = v1[2] * cs[3] - v1[3] * sn[3], y3 = v1[2] * sn[3] + v1[3] * cs[3];
                    u32x4 w; w.x = cvt_pk_bf16(x0 * s1, y0 * s1); w.y = cvt_pk_bf16(x1 * s1, y1 * s1); w.z = cvt_pk_bf16(x2 * s1, y2 * s1); w.w = cvt_pk_bf16(x3 * s1, y3 * s1);
                    __builtin_nontemporal_store(w, (u32x4*)(rowp + bj * HALF));
                    if (!isq) { u32x4 wb; wb.x = cvt_pk_bf16(x0 * s2, y0 * s2); wb.y = cvt_pk_bf16(x1 * s2, y1 * s2); wb.z = cvt_pk_bf16(x2 * s2, y2 * s2); wb.w = cvt_pk_bf16(x3 * s2, y3 * s2);
                        __builtin_nontemporal_store(wb, (u32x4*)(kbp + bj * HALF)); }
                } }
    }
};
struct EpiResGate {
    static constexpr bool PERM = true, AFTER_DRAIN = false, AROWPERM = false;
    bf16_t* h;   const float* gate;   float* out; float* dry;   bf16_t* part;   const float* xsrc;
    __device__ __forceinline__ void operator()(const f32x4 (&acc)[2][2][4][2], const Unit& u, int wr, int wc, int fr, int fq) const {
        const int b = u.pm / 17, j = u.pm - b * 17; const int v = (j == 0) ? 4 : b;
        const int row0 = u.pm * BM + wr * 64 + fr, col0 = u.pn * BM + wc * 32 + 8 * fq;
        if (u.aux >= 0) {
            bf16_t* pp = part + ((size_t)u.aux * 1024 + b * 256 + wr * 64 + fr) * 2048 + col0;
#pragma unroll
            for (int ai = 0; ai < 2; ++ai)
#pragma unroll
                for (int m = 0; m < 4; ++m)
#pragma unroll
                    for (int bj = 0; bj < 2; ++bj) { const f32x4 y0 = acc[ai][bj][m][0], y1 = acc[ai][bj][m][1];
                        u32x4 w; w.x = pk2h(y0.x, y0.y); w.y = pk2h(y0.z, y0.w); w.z = pk2h(y1.x, y1.y); w.w = pk2h(y1.z, y1.w);
                        *(u32x4*)(pp + (size_t)(ai * HALF + m * 16) * 2048 + bj * HALF) = w; }
            return;
        }
        const float* g = gate + (size_t)v * 12288;
        f32x4 gv[2][2];
#pragma unroll
        for (int bj = 0; bj < 2; ++bj)
#pragma unroll
            for (int n = 0; n < 2; ++n) gv[bj][n] = *(const f32x4*)(g + col0 + bj * HALF + n * 4);
        float* dst = nullptr; long roff = 0;
        if (dry != nullptr) { dst = dry; } else if (out != nullptr) { dst = out; roff = (long)b * 4096 - 256 - (long)b * 4352; }
#pragma unroll
        for (int ai = 0; ai < 2; ++ai) {
            if (xsrc != nullptr) {
                f32x4 x[4][2][2];
#pragma unroll
                for (int m = 0; m < 4; ++m) { const long r = row0 + ai * HALF + m * 16; const float* src = xsrc + (size_t)(r + (long)b * 4096 - 256 - (long)b * 4352) * 2048 + col0;
#pragma unroll
                    for (int bj = 0; bj < 2; ++bj)
#pragma unroll
                        for (int n = 0; n < 2; ++n) x[m][bj][n] = *(const f32x4*)(src + bj * HALF + n * 4); }
#pragma unroll
                for (int m = 0; m < 4; ++m) { const long r = row0 + ai * HALF + m * 16; bf16_t* hp = h + (size_t)r * 2048 + col0;
#pragma unroll
                    for (int bj = 0; bj < 2; ++bj) { const f32x4 y0 = x[m][bj][0] + gv[bj][0] * acc[ai][bj][m][0], y1 = x[m][bj][1] + gv[bj][1] * acc[ai][bj][m][1];
                        if (dst != nullptr) { float* dp = dst + (size_t)(r + roff) * 2048 + col0 + bj * HALF; *(f32x4*)dp = y0; *(f32x4*)(dp + 4) = y1; }
                        else { u32x4 w; w.x = pk2h(y0.x, y0.y); w.y = pk2h(y0.z, y0.w); w.z = pk2h(y1.x, y1.y); w.w = pk2h(y1.z, y1.w); *(u32x4*)(hp + bj * HALF) = w; } } }
            } else {
                u32x4 x[4][2];
#pragma unroll
                for (int m = 0; m < 4; ++m) { const long r = row0 + ai * HALF + m * 16; const bf16_t* src = h + (size_t)r * 2048 + col0;
#pragma unroll
                    for (int bj = 0; bj < 2; ++bj) x[m][bj] = *(const u32x4*)(src + bj * HALF); }
#pragma unroll
                for (int m = 0; m < 4; ++m) { const long r = row0 + ai * HALF + m * 16; bf16_t* hp = h + (size_t)r * 2048 + col0;
#pragma unroll
                    for (int bj = 0; bj < 2; ++bj) { const u32x4 xw = x[m][bj];
                        const f32x4 y0 = (f32x4){h_lo(xw.x), h_hi(xw.x), h_lo(xw.y), h_hi(xw.y)} + gv[bj][0] * acc[ai][bj][m][0];
                        const f32x4 y1 = (f32x4){h_lo(xw.z), h_hi(xw.z), h_lo(xw.w), h_hi(xw.w)} + gv[bj][1] * acc[ai][bj][m][1];
                        if (dst != nullptr) { float* dp = dst + (size_t)(r + roff) * 2048 + col0 + bj * HALF; *(f32x4*)dp = y0; *(f32x4*)(dp + 4) = y1; }
                        else { u32x4 w; w.x = pk2h(y0.x, y0.y); w.y = pk2h(y0.z, y0.w); w.z = pk2h(y1.x, y1.y); w.w = pk2h(y1.z, y1.w); *(u32x4*)(hp + bj * HALF) = w; } } }
            }
        }
    }
};
template <class Epi, class Sched, bool ALIGN_EPI = false, bool SP2 = false>
__device__ __forceinline__ void gemm_phase(PG8_LAS unsigned char* lds, const Gemm g, const Sched& S, const Epi& E, int wave) {
    const int tid = tid_of(wave); const int wid = __builtin_amdgcn_readfirstlane(tid >> 6), lane = tid & 63, wr = wid >> 2, wc = wid & 3, fr = lane & 15, fq = lane >> 4;
    const int K = g.K;
    unsigned voffA[2], voffB[2];
#pragma unroll
    for (int i = 0; i < 2; ++i) { int R, C; stage_rc(tid * 16 + i * 8192, R, C); const int Rb = Epi::PERM ? ((R & ~31) + perm32(R & 31)) : R;
        const int Ra = Epi::AROWPERM ? ((R & 64) + 4 * (R & 15) + ((R >> 4) & 3)) : R;
        voffA[i] = (unsigned)(Ra * K + C) * 2u; voffB[i] = (unsigned)(Rb * K + C) * 2u; }
    const size_t kstep = (size_t)(BK * 2);
    const size_t hstep = (size_t)HALF * K * 2;
    const size_t tstep = 2 * hstep;
    const unsigned ldsw = (unsigned)wid * 1024u;
    const int aoff = lds_byte(wr * 64 + fr, fq * 8), boff = lds_byte(wc * 32 + fr, fq * 8);
#define PG8_SA(b, h) (((b) * 2 + (h)) * HTB)
#define PG8_SB(b, h) ((4 + (b) * 2 + (h)) * HTB)
#define PG8_STAGE(bufoff, gbase, voff) do { _Pragma("unroll") for (int _i = 0; _i < 2; ++_i) \
        __builtin_amdgcn_global_load_lds((const unsigned*)((const char*)(gbase) + (voff)[_i]), (PG8_LAS unsigned*)(lds + (bufoff) + ldsw + _i * 8192), 16, 0, 0); } while (0)
#define PG8_LDA(dst, b, h) do { _Pragma("unroll") for (int m = 0; m < 4; ++m) _Pragma("unroll") for (int k = 0; k < 2; ++k) dst[m][k] = *(const PG8_LAS bf16x8*)(lds + PG8_SA(b, h) + aoff + m * 2048 + k * 1024); } while (0)
#define PG8_LDB(dst, b, h) do { _Pragma("unroll") for (int n = 0; n < 2; ++n) _Pragma("unroll") for (int k = 0; k < 2; ++k) dst[n][k] = *(const PG8_LAS bf16x8*)(lds + PG8_SB(b, h) + boff + n * 2048 + k * 1024); } while (0)
#define PG8_MMA(ai, bj, At, Bt) do { __builtin_amdgcn_s_setprio(1); _Pragma("unroll") for (int m = 0; m < 4; ++m) _Pragma("unroll") for (int n = 0; n < 2; ++n) _Pragma("unroll") for (int k = 0; k < 2; ++k) \
        acc[ai][bj][m][n] = __builtin_amdgcn_mfma_f32_16x16x32_bf16(Bt[n][k], At[m][k], acc[ai][bj][m][n], 0, 0, 0); __builtin_amdgcn_s_setprio(0); } while (0)
#define PG8_WAIT_V(n) asm volatile("s_waitcnt vmcnt(" #n ")" ::: "memory")
#define PG8_WAIT_L(n) asm volatile("s_waitcnt lgkmcnt(" #n ")" ::: "memory")
#define PG8_BAR __builtin_amdgcn_s_barrier()
#define PG8_SCHED __builtin_amdgcn_sched_barrier(0)
    Unit cur, nxt; int ui = 0;
    if (!S.next(0, cur)) return;
    f32x4 acc[2][2][4][2];
#pragma unroll
    for (int a = 0; a < 2; ++a)
#pragma unroll
        for (int b = 0; b < 2; ++b)
#pragma unroll
            for (int m = 0; m < 4; ++m)
#pragma unroll
                for (int n = 0; n < 2; ++n) acc[a][b][m][n] = (f32x4){0.f, 0.f, 0.f, 0.f};
    bf16x8 At[4][2], B0[2][2], B1[2][2];
    const char* cA = (const char*)g.A + (size_t)cur.pm * tstep + (size_t)cur.k0 * 2; const char* cB = (const char*)g.Bt + (size_t)cur.pn * tstep + (size_t)cur.k0 * 2;
    S.a_ready(cur);
    if constexpr (SP2) {
        PG8_STAGE(PG8_SB(0, 0), cB, voffB); PG8_STAGE(PG8_SB(0, 1), cB + hstep, voffB); PG8_STAGE(PG8_SA(0, 0), cA, voffA); PG8_STAGE(PG8_SA(0, 1), cA + hstep, voffA);
        if (wr == 1) PG8_BAR;
        PG8_WAIT_V(2); PG8_BAR;
        PG8_STAGE(PG8_SB(1, 0), cB + kstep, voffB); PG8_STAGE(PG8_SA(1, 0), cA + kstep, voffA); PG8_STAGE(PG8_SB(1, 1), cB + hstep + kstep, voffB);
        PG8_WAIT_V(6); PG8_BAR;
    } else {
        PG8_STAGE(PG8_SB(0, 0), cB, voffB); PG8_STAGE(PG8_SA(0, 0), cA, voffA); PG8_STAGE(PG8_SB(0, 1), cB + hstep, voffB); PG8_STAGE(PG8_SA(0, 1), cA + hstep, voffA);
        if (wr == 1) PG8_BAR;
        PG8_WAIT_V(4); PG8_BAR;
        PG8_STAGE(PG8_SB(1, 0), cB + kstep, voffB); PG8_STAGE(PG8_SA(1, 0), cA + kstep, voffA); PG8_STAGE(PG8_SB(1, 1), cB + hstep + kstep, voffB);
        PG8_WAIT_V(6); PG8_BAR;
    }
    for (;;) {
        const bool has_next = S.next(ui + 1, nxt);
        const char* nA = has_next ? (const char*)g.A + (size_t)nxt.pm * tstep + (size_t)nxt.k0 * 2 : cA; const char* nB = has_next ? (const char*)g.Bt + (size_t)nxt.pn * tstep + (size_t)nxt.k0 * 2 : cB;
        const int nt = cur.nt;
        for (int t = 0; t < nt; t += 2) {
            const bool last = (t == nt - 2);
            const char* a1 = cA + (size_t)(t + 1) * kstep;
            const char* a2 = last ? nA : cA + (size_t)(t + 2) * kstep; const char* b2 = last ? nB : cB + (size_t)(t + 2) * kstep;
            const char* a3 = a2 + kstep; const char* b3 = b2 + kstep;
            if (last && has_next) S.a_ready(nxt);
            if constexpr (SP2) {
            PG8_LDB(B0, 0, 0); PG8_LDB(B1, 0, 1); PG8_SCHED; PG8_LDA(At, 0, 0); PG8_STAGE(PG8_SA(1, 1), a1 + hstep, voffA);
            PG8_WAIT_V(8); PG8_WAIT_L(0); PG8_BAR; PG8_MMA(0, 0, At, B0); PG8_MMA(0, 1, At, B1); PG8_BAR; PG8_SCHED;
            PG8_LDA(At, 0, 1); PG8_STAGE(PG8_SB(0, 0), b2, voffB); PG8_STAGE(PG8_SB(0, 1), b2 + hstep, voffB); PG8_STAGE(PG8_SA(0, 0), a2, voffA);
            PG8_WAIT_V(8); PG8_WAIT_L(0); PG8_BAR; PG8_MMA(1, 0, At, B0); PG8_MMA(1, 1, At, B1); PG8_BAR; PG8_SCHED;
            PG8_LDB(B0, 1, 0); PG8_LDB(B1, 1, 1); PG8_SCHED; PG8_LDA(At, 1, 0); PG8_STAGE(PG8_SA(0, 1), a2 + hstep, voffA);
            PG8_WAIT_V(8); PG8_WAIT_L(0); PG8_BAR; PG8_MMA(0, 0, At, B0); PG8_MMA(0, 1, At, B1); PG8_BAR; PG8_SCHED;
            PG8_LDA(At, 1, 1); PG8_STAGE(PG8_SB(1, 0), b3, voffB); PG8_STAGE(PG8_SB(1, 1), b3 + hstep, voffB); PG8_STAGE(PG8_SA(1, 0), a3, voffA);
            PG8_WAIT_V(8); PG8_WAIT_L(0); PG8_BAR; PG8_MMA(1, 0, At, B0); PG8_MMA(1, 1, At, B1); PG8_BAR; PG8_SCHED;
            } else {
            PG8_LDB(B0, 0, 0); PG8_SCHED; PG8_LDA(At, 0, 0); PG8_STAGE(PG8_SA(1, 1), a1 + hstep, voffA);
            PG8_WAIT_L(8); PG8_BAR; PG8_WAIT_L(0); PG8_MMA(0, 0, At, B0); PG8_BAR; PG8_SCHED;
            PG8_LDB(B1, 0, 1); PG8_STAGE(PG8_SB(0, 0), b2, voffB);
            PG8_BAR; PG8_WAIT_L(0); PG8_MMA(0, 1, At, B1); PG8_BAR;
            PG8_LDA(At, 0, 1); PG8_STAGE(PG8_SA(0, 0), a2, voffA);
            PG8_BAR; PG8_WAIT_L(0); PG8_MMA(1, 0, At, B0); PG8_BAR; PG8_SCHED;
            PG8_STAGE(PG8_SB(0, 1), b2 + hstep, voffB);
            PG8_WAIT_V(6); PG8_BAR; PG8_MMA(1, 1, At, B1); PG8_BAR;
            PG8_LDB(B0, 1, 0); PG8_SCHED; PG8_LDA(At, 1, 0); PG8_STAGE(PG8_SA(0, 1), a2 + hstep, voffA);
            PG8_WAIT_L(8); PG8_BAR; PG8_WAIT_L(0); PG8_MMA(0, 0, At, B0); PG8_BAR; PG8_SCHED;
            PG8_LDB(B1, 1, 1); PG8_STAGE(PG8_SB(1, 0), b3, voffB);
            PG8_BAR; PG8_WAIT_L(0); PG8_MMA(0, 1, At, B1); PG8_BAR;
            PG8_LDA(At, 1, 1); PG8_STAGE(PG8_SA(1, 0), a3, voffA);
            PG8_BAR; PG8_WAIT_L(0); PG8_MMA(1, 0, At, B0); PG8_BAR; PG8_SCHED;
            PG8_STAGE(PG8_SB(1, 1), b3 + hstep, voffB);
            PG8_WAIT_V(6); PG8_BAR; PG8_MMA(1, 1, At, B1); PG8_BAR;
            }
        }
        if constexpr (ALIGN_EPI) { if (wr == 0) PG8_BAR; }
        if constexpr (!Epi::AFTER_DRAIN) { E(acc, cur, wr, wc, fr, fq); S.done(cur); }
        if (!has_next) break;
#pragma unroll
        for (int a = 0; a < 2; ++a)
#pragma unroll
            for (int b = 0; b < 2; ++b)
#pragma unroll
                for (int m = 0; m < 4; ++m)
#pragma unroll
                    for (int n = 0; n < 2; ++n) acc[a][b][m][n] = (f32x4){0.f, 0.f, 0.f, 0.f};
        cur = nxt; cA = nA; cB = nB; ++ui;
        if constexpr (ALIGN_EPI) { if (wr == 1) PG8_BAR; }
    }
    PG8_WAIT_V(0);
    if constexpr (!ALIGN_EPI) { if (wr == 0) PG8_BAR; }
    PG8_BAR;
    if constexpr (Epi::AFTER_DRAIN) { E.fused(acc, cur, wr, wc, fr, fq, lds, wid, lane); S.done(cur); }
#undef PG8_SA
#undef PG8_SB
#undef PG8_STAGE
#undef PG8_LDA
#undef PG8_LDB
#undef PG8_MMA
#undef PG8_WAIT_V
#undef PG8_WAIT_L
#undef PG8_BAR
#undef PG8_SCHED
}
}
#define GAS __attribute__((address_space(1)))
#define LAS __attribute__((address_space(3)))
typedef unsigned short bf16;
typedef unsigned v4u __attribute__((ext_vector_type(4)));
typedef unsigned v2u __attribute__((ext_vector_type(2)));
typedef float f32x4 __attribute__((ext_vector_type(4)));
typedef float f32x16 __attribute__((ext_vector_type(16)));
typedef short bf16x8 __attribute__((ext_vector_type(8)));
typedef short s16x4 __attribute__((ext_vector_type(4)));
typedef GAS unsigned gu32;
#define RLX_AGENT __ATOMIC_RELAXED, __HIP_MEMORY_SCOPE_AGENT
#define LDS_WAIT() asm volatile("s_waitcnt lgkmcnt(0)" ::: "memory")
#define VM_WAIT() asm volatile("s_waitcnt vmcnt(0)" ::: "memory")
#define SBAR() __builtin_amdgcn_sched_barrier(0)
__device__ __forceinline__ unsigned f2bf(float f) { unsigned u = __builtin_bit_cast(unsigned, f); return (u + 0x7fffu + ((u >> 16) & 1u)) >> 16; }
typedef float f32x2_t __attribute__((ext_vector_type(2)));
typedef __bf16 bf16x2_t __attribute__((ext_vector_type(2)));
__device__ __forceinline__ unsigned pk2(float lo, float hi) { f32x2_t v = {lo, hi}; bf16x2_t b = __builtin_convertvector(v, bf16x2_t); return __builtin_bit_cast(unsigned, b); }
__device__ __forceinline__ float bf_lo(unsigned w) { return __builtin_bit_cast(float, w << 16); }
__device__ __forceinline__ float bf_hi(unsigned w) { return __builtin_bit_cast(float, w & 0xffff0000u); }
__device__ __forceinline__ unsigned cvtpk(float lo, float hi) { unsigned r; asm volatile("v_cvt_pk_bf16_f32 %0, %1, %2" : "=v"(r) : "v"(lo), "v"(hi)); return r; }
template <int CTRL> __device__ __forceinline__ float dppx(float x) { return __builtin_bit_cast(float, __builtin_amdgcn_update_dpp(0, __builtin_bit_cast(int, x), CTRL, 0xf, 0xf, true)); }
__device__ __forceinline__ float wave_sum(float v) {
    v += dppx<0xB1>(v);
    v += dppx<0x4E>(v);
    v += dppx<0x141>(v);
    v += dppx<0x140>(v);
    { auto r = __builtin_amdgcn_permlane16_swap(__float_as_uint(v), __float_as_uint(v), false, false); v = __uint_as_float(r[0]) + __uint_as_float(r[1]); }
    { auto r = __builtin_amdgcn_permlane32_swap(__float_as_uint(v), __float_as_uint(v), false, false); v = __uint_as_float(r[0]) + __uint_as_float(r[1]); }
    return v;
}
__device__ __forceinline__ float silu_f(float x) { return x * __builtin_amdgcn_rcpf(1.f + __builtin_amdgcn_exp2f(-1.4426950408889634f * x)); }
__device__ __forceinline__ void sincos_cw(float a, float& s, float& c) {
    const float k = rintf(a * 0.15915494309189535f);
    float r = fmaf(-k, 6.2831854820251465f, a);
    r = fmaf(-k, -1.7484555314695172e-07f, r);
    s = __sinf(r); c = __cosf(r);
}
__device__ __forceinline__ int opaque_tid(int wave) { return pg8::tid_of(wave); }
__device__ __forceinline__ unsigned cvtpk_s(float lo, float hi) { f32x2_t v = {lo, hi}; bf16x2_t b = __builtin_convertvector(v, bf16x2_t); return __builtin_bit_cast(unsigned, b); }
#define XB_TMO      128
#define XB_XCNT(j)  (256  + 64 * (j))
#define XB_XSUB(j)  (1280 + 64 * (j))
#define XB_XGEN(j)  (2304 + 64 * (j))
#define XB_TOP      3328
#define XB_TOPGEN   3392
#define XCD_BAR_WORDS 3456
#define XB_SPIN_CAP (1u << 18)

__device__ __forceinline__ unsigned xb_ld(unsigned* p)              { return __hip_atomic_load(p, __ATOMIC_RELAXED, __HIP_MEMORY_SCOPE_AGENT); }
__device__ __forceinline__ unsigned xb_add(unsigned* p, unsigned v) { return __hip_atomic_fetch_add(p, v, __ATOMIC_RELAXED, __HIP_MEMORY_SCOPE_AGENT); }
__device__ __forceinline__ unsigned xb_xcc_id() { return (unsigned)__builtin_amdgcn_s_getreg((3 << 11) | 20) & 0xFu; }
#define XB_SPIN(cond, bar) do { unsigned _sp = 0; while (cond) { __builtin_amdgcn_s_sleep(1); \
    if ((++_sp & 255u) == 0u) { if (xb_ld(&(bar)[XB_TMO])) break; if (_sp > XB_SPIN_CAP) { atomicAdd(&(bar)[XB_TMO], 1u); break; } } } } while (0)

struct XcdBarrier {
    unsigned* bar; unsigned x; int wv;
    volatile LAS unsigned* st;
};

__device__ __forceinline__ XcdBarrier xcd_barrier_post(unsigned* bar, volatile LAS unsigned* st) {
    XcdBarrier b; b.bar = bar; b.x = xb_xcc_id(); b.st = st; b.wv = __builtin_amdgcn_readfirstlane(threadIdx.x >> 6);
    if (threadIdx.x == 0) (void)xb_add(&bar[XB_XCNT(b.x)], 1u);
    return b;
}
__device__ __forceinline__ void xcd_barrier_complete(unsigned* bar, unsigned x, unsigned& nloc, unsigned& nx) {
    const unsigned G = gridDim.x * gridDim.y * gridDim.z;
    unsigned sum, cnt, mine, sp = 0u;
    for (;;) {
        sum = 0u; cnt = 0u; mine = 0u;
#pragma unroll
        for (unsigned j = 0; j < 16; ++j) { const unsigned c = xb_ld(&bar[XB_XCNT(j)]); sum += c; cnt += (c > 0u) ? 1u : 0u; mine = (j == x) ? c : mine; }
        if (sum == G) break;
        __builtin_amdgcn_s_sleep(1);
        if ((++sp & 255u) == 0u) { if (xb_ld(&bar[XB_TMO])) break; if (sp > XB_SPIN_CAP) { atomicAdd(&bar[XB_TMO], 1u); break; } }
    }
    nloc = mine > 0u ? mine : 1u; nx = cnt > 0u ? cnt : 1u;
}

__device__ __forceinline__ void xcd_barrier(const XcdBarrier& b) {
    asm volatile("s_waitcnt vmcnt(0)" ::: "memory");
    __syncthreads();
    if (pg8::tid_of(b.wv) == 0) {
        unsigned* bar = b.bar;
        __builtin_amdgcn_s_waitcnt(0);
        unsigned nloc = b.st[0], nx = b.st[1];
        if (nloc == 0u) { xcd_barrier_complete(bar, b.x, nloc, nx); b.st[0] = nloc; b.st[1] = nx; }
        const unsigned old = xb_add(&bar[XB_XSUB(b.x)], 1u);
        const unsigned gen = old / nloc;
        if (old + 1u == (gen + 1u) * nloc) {
            __builtin_amdgcn_fence(__ATOMIC_RELEASE, "agent");
            asm volatile("s_waitcnt vmcnt(0)" ::: "memory");
            const unsigned og = xb_add(&bar[XB_TOP], 1u);
            const unsigned tg = og / nx;
            if (og + 1u == (tg + 1u) * nx) xb_add(&bar[XB_TOPGEN], 1u);
            else XB_SPIN(xb_ld(&bar[XB_TOPGEN]) == tg, bar);
            __builtin_amdgcn_fence(__ATOMIC_ACQUIRE, "agent");
            xb_add(&bar[XB_XGEN(b.x)], 1u);
            asm volatile("s_waitcnt vmcnt(0)" ::: "memory");
        } else {
            XB_SPIN(xb_ld(&bar[XB_XGEN(b.x)]) == gen, bar);
            __builtin_amdgcn_fence(__ATOMIC_ACQUIRE, "agent");
            asm volatile("s_waitcnt vmcnt(0)" ::: "memory");
        }
    }
    __syncthreads();
}
constexpr int NWAVES = 8, NTHR = 512;
constexpr int DM = 2048, NB = 4, SEQ = 4096, CTXL = 256, RPB = SEQ + CTXL  , MROWS = NB * RPB  ;
constexpr int DFF = 5632, DFF2 = 2 * DFF, DEPTH = 4, MODW = 6 * DM  ;
constexpr int GA_N = 3072, RT_N = 16384, DF_N = 6144, RT_V = 4096;
constexpr float EPS = 1e-6f;
constexpr size_t MiB = 1u << 20;
constexpr size_t WS_CTL = 0, CTL_ZERO_BYTES = 1 * MiB;
constexpr size_t WS_MOD = 16 * MiB;
constexpr size_t WS_W_FFN_IN = 17 * MiB;
constexpr size_t WS_W_FFN_OUT = 193 * MiB;
constexpr size_t WS_W_GA_QKV = 281 * MiB;
constexpr size_t WS_W_GA_WO = 305 * MiB;
constexpr size_t WS_W_RT_IN = 321 * MiB;
constexpr size_t WS_W_RT_WO = 385 * MiB;
constexpr size_t WS_W_DF_QKV = 401 * MiB;
constexpr size_t WS_W_DF_WO = 425 * MiB;
constexpr size_t WS_H = 433 * MiB;
constexpr size_t WS_ABUF = 569 * MiB;
constexpr size_t WS_PROJ = 637 * MiB;
constexpr size_t WS_OBUF = 1181 * MiB;
constexpr size_t WS_XBUF = 1368 * MiB, WS_MODP = WS_XBUF;
constexpr size_t WS_ROPE = 1504 * MiB;
constexpr size_t WS_ROPE_RT = 1506 * MiB;
constexpr size_t WS_END = 1510 * MiB;
constexpr int PART_G = 256, PART_GEMM = 208;
constexpr int CW_DQ_NEXT = 64, CW_DQ_DONE = 128;
constexpr unsigned DQ_STOP_AT = 17;
constexpr int MOD_KS = 32;
constexpr int CW_BAR = 4096;
constexpr int RING_BYTES = 131072, MISC_OFF = RING_BYTES + 320, LDS_BYTES = 147456;
struct Frame {
    LAS unsigned char* lds;
    volatile LAS unsigned* MISC;
    gu32* ctl;
    int tid, lane, wave, G, bid, gw, NGW;
};
struct Args { const float* in[24]; float* out; unsigned char* ws; int ph_lo, ph_hi; };

struct TrDesc { const float* W; bf16* WT; int K, N, item, abpair, qkcols, hd; };
__device__ __forceinline__ void tr_load(f32x4 (&wv)[8], const TrDesc& d, int lane) {
    const int nblk = d.N / 32, kb = d.item / nblk, nb = d.item % nblk, k0 = 64 * kb, n0 = 32 * nb;
    const int r8 = lane >> 3, c4 = (lane & 7) * 4;
#pragma unroll
    for (int i = 0; i < 8; ++i) wv[i] = __builtin_nontemporal_load((const GAS f32x4*)(d.W + (size_t)(k0 + 8 * i + r8) * d.N + n0 + c4));
}
__device__ __forceinline__ void tr_finish(const f32x4 (&wv)[8], const TrDesc& d, LAS float* scr, int lane) {
    const int nblk = d.N / 32, kb = d.item / nblk, nb = d.item % nblk, k0 = 64 * kb, n0 = 32 * nb;
    { const int r8 = lane >> 3, c4 = (lane & 7) * 4;
#pragma unroll
      for (int i = 0; i < 8; ++i) { LAS float* q = scr + (8 * i + r8) * 33 + c4; q[0] = wv[i].x; q[1] = wv[i].y; q[2] = wv[i].z; q[3] = wv[i].w; } }
    LDS_WAIT(); asm volatile("" ::: "memory");
    const int c = lane & 7;
#pragma unroll
    for (int j = 0; j < 4; ++j) { const int n = (lane >> 3) + 8 * j; const LAS float* s = scr + (8 * c) * 33 + n;
        v4u o; o.x = pk2(s[0 * 33], s[1 * 33]); o.y = pk2(s[2 * 33], s[3 * 33]); o.z = pk2(s[4 * 33], s[5 * 33]); o.w = pk2(s[6 * 33], s[7 * 33]);
        int drow = n0 + n; if (drow < d.qkcols) { const int dd = drow & (d.hd - 1), hh = d.hd >> 1; drow = (drow & ~(d.hd - 1)) + (dd < hh ? 2 * dd : 2 * (dd - hh) + 1); }
        if (d.abpair) { const int cc = drow < 5632 ? drow : drow - 5632; drow = (cc >> 7) * 256 + (cc & 127) + (drow < 5632 ? 0 : 128); }
        __builtin_nontemporal_store(o, (GAS v4u*)(d.WT + (size_t)drow * d.K + k0 + 8 * c)); }
    LDS_WAIT(); asm volatile("" ::: "memory");
}
constexpr int WI_FI = (DM / 64) * (DFF2 / 32), WI_FO = (DFF / 64) * (DM / 32), WI_GQ = (DM / 64) * (GA_N / 32), WI_GO = (DM / 64) * (DM / 32),
              WI_RI = (DM / 64) * (RT_N / 32), WI_RO = (RT_V / 64) * (DM / 32), WI_DQ = (DM / 64) * (DF_N / 32), WI_DO = (DM / 64) * (DM / 32);
constexpr int W_EARLY = WI_GQ + WI_GO, W_NITEMS = 4 * WI_FI + 4 * WI_FO + 2 * WI_GQ + 2 * WI_GO + WI_RI + WI_RO + WI_DQ + WI_DO;
__device__ __forceinline__ TrDesc p0_weight_desc(const Args& a, int r) {
    unsigned char* ws = a.ws;
    if (r < WI_GQ) return TrDesc{a.in[11], (bf16*)(ws + WS_W_GA_QKV), DM, GA_N, r, 0, 2560, 128}; r -= WI_GQ;
    if (r < WI_GO) return TrDesc{a.in[14], (bf16*)(ws + WS_W_GA_WO), DM, DM, r, 0, 0, 128}; r -= WI_GO;
    if (r < 4 * WI_FI) { const int l = r / WI_FI; return TrDesc{a.in[7] + (size_t)l * DM * DFF2, (bf16*)(ws + WS_W_FFN_IN) + (size_t)l * DFF2 * DM, DM, DFF2, r % WI_FI, 1, 0, 128}; } r -= 4 * WI_FI;
    if (r < 4 * WI_FO) { const int l = r / WI_FO; return TrDesc{a.in[10] + (size_t)l * DFF * DM, (bf16*)(ws + WS_W_FFN_OUT) + (size_t)l * DM * DFF, DFF, DM, r % WI_FO, 0, 0, 128}; } r -= 4 * WI_FO;
    if (r < WI_RI) return TrDesc{a.in[15], (bf16*)(ws + WS_W_RT_IN), DM, RT_N, r, 0, 4096, 256}; r -= WI_RI;
    if (r < WI_RO) return TrDesc{a.in[18], (bf16*)(ws + WS_W_RT_WO), RT_V, DM, r, 0, 0, 128}; r -= WI_RO;
    if (r < WI_DQ) return TrDesc{a.in[19], (bf16*)(ws + WS_W_DF_QKV), DM, DF_N, r, 0, 4096, 128}; r -= WI_DQ;
    if (r < WI_DO) return TrDesc{a.in[23], (bf16*)(ws + WS_W_DF_WO), DM, DM, r, 0, 0, 128}; r -= WI_DO;
    if (r < WI_GQ) return TrDesc{a.in[11] + (size_t)DM * GA_N, (bf16*)(ws + WS_W_GA_QKV) + (size_t)GA_N * DM, DM, GA_N, r, 0, 2560, 128}; r -= WI_GQ;
    return TrDesc{a.in[14] + (size_t)DM * DM, (bf16*)(ws + WS_W_GA_WO) + (size_t)DM * DM, DM, DM, r, 0, 0, 128};
}
__device__ __forceinline__ void p0_weight_item(const Args& a, LAS float* scr, int r, int lane) { const TrDesc d = p0_weight_desc(a, r); f32x4 wv[8]; tr_load(wv, d, lane); tr_finish(wv, d, scr, lane); }
__device__ __forceinline__ void dq_work(Frame& F0, const Args& a, bool until_gemm) {
    Frame F = F0; F.tid = opaque_tid(F0.wave); F.lane = F.tid & 63;
    if (F.G != PART_G) return;
    LAS float* scr = (LAS float*)(F.lds + F.wave * 16384);
    unsigned* ctl = (unsigned*)F.ctl;
    constexpr unsigned NDEF = (unsigned)(W_NITEMS - W_EARLY);
    if (!until_gemm) {
        unsigned r0 = 0u; if (F.lane == 0) r0 = xb_ld(&ctl[CW_DQ_NEXT]); r0 = (unsigned)__builtin_amdgcn_readfirstlane((int)r0);
        for (unsigned it = r0 + (unsigned)F.gw; it < NDEF; it += (unsigned)F.NGW) p0_weight_item(a, scr, W_EARLY + (int)it, F.lane);
        return;
    }
    static_assert(NDEF % 2u == 0u, "pairs");
    unsigned pa = 0u, pb = 0u; if (F.lane == 0) { pa = xb_add(&ctl[CW_DQ_NEXT], 2u); pb = xb_add(&ctl[CW_DQ_NEXT], 2u); }
    pa = (unsigned)__builtin_amdgcn_readfirstlane((int)pa); pb = (unsigned)__builtin_amdgcn_readfirstlane((int)pb);
    unsigned seen = 0u;
    f32x4 wvA[8], wvB[8]; TrDesc dA, dB;
    if (pa < NDEF) { dA = p0_weight_desc(a, W_EARLY + (int)pa); dB = p0_weight_desc(a, W_EARLY + (int)pa + 1); tr_load(wvA, dA, F.lane); tr_load(wvB, dB, F.lane); }
    while (pa < NDEF) {
        const bool stop = until_gemm && seen >= DQ_STOP_AT;
        unsigned nn = NDEF, dn = 0u;
        if (!stop && pb < NDEF && F.lane == 0) { nn = xb_add(&ctl[CW_DQ_NEXT], 2u); if (until_gemm) dn = xb_ld(&ctl[CW_DQ_DONE]); }
        tr_finish(wvA, dA, scr, F.lane);
        if (pb < NDEF) { dA = p0_weight_desc(a, W_EARLY + (int)pb); tr_load(wvA, dA, F.lane); }
        tr_finish(wvB, dB, scr, F.lane);
        if (pb < NDEF) { dB = p0_weight_desc(a, W_EARLY + (int)pb + 1); tr_load(wvB, dB, F.lane); }
        pa = pb; pb = (unsigned)__builtin_amdgcn_readfirstlane((int)nn); seen = (unsigned)__builtin_amdgcn_readfirstlane((int)dn);
    }
}
__device__ __forceinline__ void p0_prologue(Frame& F0, const Args& a) {
    Frame F = F0; F.tid = opaque_tid(F0.wave); F.lane = F.tid & 63;
    unsigned char* ws = a.ws;
    {
        LAS float* tab = (LAS float*)F.lds;
        for (int i = F.tid; i < 2048 * 5; i += NTHR) { const int v = i / 2048, k = i % 2048; const float x = (v < 4) ? a.in[1][v * 2048 + k] : a.in[3][k]; tab[k * 8 + v] = silu_f(x); }
        __syncthreads();
        float* modp = (float*)(ws + WS_MODP);
        for (int it = F.gw; it < DEPTH * 48 * MOD_KS; it += F.NGW) {
            const int l = it / (48 * MOD_KS), r = it % (48 * MOD_KS), nb = r / MOD_KS, ks = r % MOD_KS;
            const float* W = a.in[4] + ((size_t)l * 2048 + ks * (2048 / MOD_KS)) * MODW + nb * 256 + 4 * F.lane;
            f32x4 acc[5];
#pragma unroll
            for (int v = 0; v < 5; ++v) acc[v] = (f32x4){0.f, 0.f, 0.f, 0.f};
#pragma unroll 8
            for (int kk = 0; kk < 2048 / MOD_KS; ++kk) {
                const f32x4 w = *(const GAS f32x4*)(W + (size_t)kk * MODW);
                const LAS float* t = tab + (ks * (2048 / MOD_KS) + kk) * 8;
                const f32x4 s4 = *(const LAS f32x4*)t; const float s5 = t[4];
                acc[0] += w * s4[0]; acc[1] += w * s4[1]; acc[2] += w * s4[2]; acc[3] += w * s4[3]; acc[4] += w * s5;
            }
#pragma unroll
            for (int v = 0; v < 5; ++v) *(GAS f32x4*)(modp + ((size_t)(l * MOD_KS + ks) * 5 + v) * MODW + nb * 256 + 4 * F.lane) = acc[v];
        }
        __syncthreads();
    }
    {
        LAS float* scr = (LAS float*)(F.lds + F.wave * 16384);
        const int nit = (F.G == PART_G) ? W_EARLY : W_NITEMS;
        for (int it = F.gw; it < nit; it += F.NGW) p0_weight_item(a, scr, it, F.lane);
    }
    {
        float* tab = (float*)(ws + WS_ROPE);
        for (int i = F.bid * NTHR + F.tid; i < SEQ * 64; i += F.G * NTHR) {
            const int t = i >> 6, p = i & 63;
            const float inv = exp2f(-(float)(p & 31) * 0.4152410118609203f);
            const float pos = (float)((p < 32) ? (t >> 6) : (t & 63));
            float sn, cs; sincos_cw(pos * inv, sn, cs);
            tab[(size_t)t * 128 + p] = cs; tab[(size_t)t * 128 + 64 + p] = sn;
        }
        float* tab2 = (float*)(ws + WS_ROPE_RT);
        for (int i = F.bid * NTHR + F.tid; i < SEQ * 128; i += F.G * NTHR) {
            const int t = i >> 7, p = i & 127;
            const float inv = exp2f(-(float)p * 0.10381025296523008f);
            float sn, cs; sincos_cw((float)t * inv, sn, cs);
            tab2[(size_t)t * 256 + p] = cs; tab2[(size_t)t * 256 + 128 + p] = sn;
        }
    }
}
__device__ __forceinline__ void p0b_modfinal(Frame& F0, const Args& a) {
    Frame F = F0; F.tid = opaque_tid(F0.wave); F.lane = F.tid & 63;
    const float* modp = (const float*)(a.ws + WS_MODP); float* mod = (float*)(a.ws + WS_MOD);
    for (int i = F.bid * NTHR + F.tid; i < DEPTH * 5 * MODW; i += F.G * NTHR) {
        const int n = i % MODW, v = (i / MODW) % 5, l = i / (5 * MODW);
        float s = a.in[5][l * MODW + n];
#pragma unroll
        for (int ks = 0; ks < MOD_KS; ++ks) s += modp[((size_t)(l * MOD_KS + ks) * 5 + v) * MODW + n];
        mod[i] = s;
    }
}
__device__ __forceinline__ int norm_col(int lane, int q) { return 8 * lane + 512 * (q >> 1) + 4 * (q & 1); }
__device__ __forceinline__ void norm_load_row(f32x4 (&x)[8], const float* fsrc, const bf16* hsrc, int lane) {
    if (fsrc != nullptr) {
#pragma unroll
        for (int q = 0; q < 8; ++q) x[q] = *(const GAS f32x4*)(fsrc + norm_col(lane, q));
    } else {
        v4u w[4];
#pragma unroll
        for (int Q = 0; Q < 4; ++Q) w[Q] = *(const GAS v4u*)(hsrc + 8 * lane + 512 * Q);
#pragma unroll
        for (int Q = 0; Q < 4; ++Q) { x[2 * Q] = (f32x4){pg8::h_lo(w[Q].x), pg8::h_hi(w[Q].x), pg8::h_lo(w[Q].y), pg8::h_hi(w[Q].y)};
            x[2 * Q + 1] = (f32x4){pg8::h_lo(w[Q].z), pg8::h_hi(w[Q].z), pg8::h_lo(w[Q].w), pg8::h_hi(w[Q].w)}; }
    }
}
__device__ __forceinline__ float norm_rstd(const f32x4 (&x)[8]) {
    float ss = 0.f;
#pragma unroll
    for (int q = 0; q < 8; ++q) ss += (x[q].x * x[q].x + x[q].y * x[q].y) + (x[q].z * x[q].z + x[q].w * x[q].w);
    return __builtin_amdgcn_rsqf(wave_sum(ss) * (1.f / DM) + EPS);
}
__device__ __forceinline__ f32x4 norm_y(const f32x4 x, float rstd, const float* g, const float* sh, const float* sc, int col) {
    const f32x4 gv = *(const GAS f32x4*)(g + col), shv = *(const GAS f32x4*)(sh + col), scv = *(const GAS f32x4*)(sc + col);
    return (x * rstd * gv) * (scv + 1.f) + shv;
}
__device__ __forceinline__ void norm_mod_phase(Frame& F0, const Args& a, int layer, int which, int lat_only, const float* pgate, const float* xsrc, const float* csrc) {
    Frame F = F0; F.tid = opaque_tid(F0.wave); F.lane = F.tid & 63;
    bf16* h = (bf16*)(a.ws + WS_H); bf16* ab = (bf16*)(a.ws + WS_ABUF); const bf16* part = (const bf16*)(a.ws + WS_XBUF);
    const float* g = a.in[6] + (size_t)(layer * 2 + which) * DM;
    const float* modl = (const float*)(a.ws + WS_MOD) + (size_t)layer * 5 * MODW;
    const int wv = __builtin_amdgcn_readfirstlane(F.tid >> 6);
    if (!lat_only && wv < 4) {
        const float* sh = modl + (size_t)4 * MODW + (which * 3 + 0) * DM; const float* sc = modl + (size_t)4 * MODW + (which * 3 + 1) * DM;
        for (int crow = F.bid * 4 + wv; crow < NB * CTXL; crow += F.G * 4) {
            const size_t row = (size_t)(crow / CTXL) * RPB + (crow % CTXL);
            f32x4 x[8];
            norm_load_row(x, csrc ? csrc + (size_t)crow * DM : (const float*)nullptr, h + row * DM, F.lane);
            if (pgate != nullptr) {
#pragma unroll
                for (int Q = 0; Q < 4; ++Q) { const int col = 8 * F.lane + 512 * Q; f32x4 s0 = (f32x4){0.f, 0.f, 0.f, 0.f}, s1 = s0;
                    v4u pw[8];
#pragma unroll
                    for (int ks = 0; ks < 8; ++ks) pw[ks] = *(const GAS v4u*)(part + ((size_t)ks * 1024 + crow) * DM + col);
#pragma unroll
                    for (int ks = 0; ks < 8; ++ks) { s0 += (f32x4){pg8::h_lo(pw[ks].x), pg8::h_hi(pw[ks].x), pg8::h_lo(pw[ks].y), pg8::h_hi(pw[ks].y)};
                        s1 += (f32x4){pg8::h_lo(pw[ks].z), pg8::h_hi(pw[ks].z), pg8::h_lo(pw[ks].w), pg8::h_hi(pw[ks].w)}; }
                    x[2 * Q] += *(const GAS f32x4*)(pgate + col) * s0; x[2 * Q + 1] += *(const GAS f32x4*)(pgate + col + 4) * s1;
                    v4u hw; hw.x = pg8::pk2h(x[2 * Q].x, x[2 * Q].y); hw.y = pg8::pk2h(x[2 * Q].z, x[2 * Q].w); hw.z = pg8::pk2h(x[2 * Q + 1].x, x[2 * Q + 1].y); hw.w = pg8::pk2h(x[2 * Q + 1].z, x[2 * Q + 1].w);
                    *(GAS v4u*)(h + row * DM + col) = hw; }
            }
            const float rstd = norm_rstd(x);
#pragma unroll
            for (int Q = 0; Q < 4; ++Q) { const int col = 8 * F.lane + 512 * Q;
                const f32x4 ya = norm_y(x[2 * Q], rstd, g, sh, sc, col), yb = norm_y(x[2 * Q + 1], rstd, g, sh, sc, col + 4);
                v4u w; w.x = pk2(ya.x, ya.y); w.y = pk2(ya.z, ya.w); w.z = pk2(yb.x, yb.y); w.w = pk2(yb.z, yb.w); *(GAS v4u*)(ab + row * DM + col) = w; }
        }
    }
    const int nh = (!lat_only && pgate != nullptr) ? 3 : 4, nl = 8 - nh;
    const int ns = wv < 4 ? nh : nl, s0 = wv < 4 ? nh * wv : 4 * nh + nl * (wv - 4);
    constexpr int NPAIR = NB * SEQ / 2;
    for (int base = F.bid * 32 + s0; base < NPAIR; base += F.G * 32)
        for (int s = 0; s < ns; ++s) {
            const int p = base + s; if (p >= NPAIR) break;
            const int r0 = 2 * p, b = r0 / SEQ, t = r0 % SEQ; const size_t row = (size_t)b * RPB + CTXL + t;
            const float* sh = modl + (size_t)b * MODW + (which * 3 + 0) * DM; const float* sc = modl + (size_t)b * MODW + (which * 3 + 1) * DM;
            f32x4 x0[8], x1[8];
            norm_load_row(x0, xsrc ? xsrc + (size_t)r0 * DM : (const float*)nullptr, h + row * DM, F.lane);
            norm_load_row(x1, xsrc ? xsrc + (size_t)(r0 + 1) * DM : (const float*)nullptr, h + (row + 1) * DM, F.lane);
            const float rs0 = norm_rstd(x0), rs1 = norm_rstd(x1);
#pragma unroll
            for (int Q = 0; Q < 4; ++Q) { const int col = 8 * F.lane + 512 * Q;
                const f32x4 ga = *(const GAS f32x4*)(g + col), sha = *(const GAS f32x4*)(sh + col), sca = *(const GAS f32x4*)(sc + col) + 1.f;
                const f32x4 gb = *(const GAS f32x4*)(g + col + 4), shb = *(const GAS f32x4*)(sh + col + 4), scb = *(const GAS f32x4*)(sc + col + 4) + 1.f;
                const f32x4 y0a = (x0[2 * Q] * rs0 * ga) * sca + sha, y0b = (x0[2 * Q + 1] * rs0 * gb) * scb + shb;
                const f32x4 y1a = (x1[2 * Q] * rs1 * ga) * sca + sha, y1b = (x1[2 * Q + 1] * rs1 * gb) * scb + shb;
                v4u w0, w1; w0.x = pk2(y0a.x, y0a.y); w0.y = pk2(y0a.z, y0a.w); w0.z = pk2(y0b.x, y0b.y); w0.w = pk2(y0b.z, y0b.w);
                w1.x = pk2(y1a.x, y1a.y); w1.y = pk2(y1a.z, y1a.w); w1.z = pk2(y1b.x, y1b.y); w1.w = pk2(y1b.z, y1b.w);
                *(GAS v4u*)(ab + row * DM + col) = w0; *(GAS v4u*)(ab + (row + 1) * DM + col) = w1; }
        }
}
__device__ __forceinline__ void unpack8(const v4u w, float* x) { x[0] = bf_lo(w.x); x[1] = bf_hi(w.x); x[2] = bf_lo(w.y); x[3] = bf_hi(w.y); x[4] = bf_lo(w.z); x[5] = bf_hi(w.z); x[6] = bf_lo(w.w); x[7] = bf_hi(w.w); }
__device__ __forceinline__ void conv_fix_phase(Frame& F0, const Args& a, int layer, int lat_only) {
    Frame F = F0; F.tid = opaque_tid(F0.wave); F.lane = F.tid & 63;
    const bf16* ed = (const bf16*)(a.ws + WS_PROJ); bf16* go = (bf16*)(a.ws + WS_OBUF);
    const float* cw = a.in[8] + (size_t)layer * 3 * DFF2; const float* cb = a.in[9] + (size_t)layer * DFF2;
    constexpr int NRUN = MROWS / 64;
    for (int it = F.gw; it < (NRUN - 1) * 11; it += F.NGW) {
        const int cbk = it % 11, k = it / 11;
        const int r2 = 64 * (k + 1), j2 = r2 % RPB;
        if (j2 == 0 || j2 == CTXL) continue;
        if (lat_only && j2 < CTXL) continue;
        const int c0 = cbk * 512 + F.lane * 8;
        float wa[3][8], wb[3][8], ba[8], bb[8];
#pragma unroll
        for (int t = 0; t < 3; ++t)
#pragma unroll
            for (int e = 0; e < 8; ++e) { wa[t][e] = cw[t * DFF2 + c0 + e]; wb[t][e] = cw[t * DFF2 + DFF + c0 + e]; }
#pragma unroll
        for (int e = 0; e < 8; ++e) { ba[e] = cb[c0 + e]; bb[e] = cb[DFF + c0 + e]; }
        float xa[4][8], xb[4][8];
#pragma unroll
        for (int q = 0; q < 4; ++q) { const bf16* p = ed + ((size_t)(q < 2 ? k : k + 1) * 4 + (q < 2 ? 2 + q : q - 2)) * DFF2 + c0;
            unpack8(*(const GAS v4u*)p, xa[q]); unpack8(*(const GAS v4u*)(p + DFF), xb[q]); }
#pragma unroll
        for (int q = 0; q < 2; ++q) {
            float y[8];
#pragma unroll
            for (int e = 0; e < 8; ++e) {
                const float va = ba[e] + wa[0][e] * xa[q][e] + wa[1][e] * xa[q + 1][e] + wa[2][e] * xa[q + 2][e];
                const float vb = bb[e] + wb[0][e] * xb[q][e] + wb[1][e] * xb[q + 1][e] + wb[2][e] * xb[q + 2][e];
                y[e] = va * __builtin_amdgcn_rcpf(1.f + __builtin_amdgcn_exp2f(-1.4426950408889634f * va)) * vb; }
            v4u ow; ow.x = pk2(y[0], y[1]); ow.y = pk2(y[2], y[3]); ow.z = pk2(y[4], y[5]); ow.w = pk2(y[6], y[7]);
            *(GAS v4u*)(go + (size_t)(r2 - 1 + q) * DFF + c0) = ow;
        }
    }
}
__device__ __forceinline__ void df_combine_phase(Frame& F0, const Args& a, float linit) {
    Frame F = F0; F.tid = opaque_tid(F0.wave); F.lane = F.tid & 63;
    const bf16* O = (const bf16*)(a.ws + WS_OBUF); bf16* ab = (bf16*)(a.ws + WS_ABUF);
    const float* lam = a.in[20]; const float* sg = a.in[22];
    float l0 = lam[F.lane] * lam[128 + F.lane] + lam[64 + F.lane] * lam[192 + F.lane];
    float l1 = lam[256 + F.lane] * lam[384 + F.lane] + lam[320 + F.lane] * lam[448 + F.lane];
    l0 = wave_sum(l0); l1 = wave_sum(l1);
    const float lmb = expf(l0) - expf(l1) + linit;
    const f32x4 sgv = *(const GAS f32x4*)(sg + 4 * F.lane);
    for (int row = F.gw; row < MROWS; row += F.NGW) {
        v2u w0[8], w1[8];
#pragma unroll
        for (int hh = 0; hh < 8; ++hh) { w0[hh] = *(const GAS v2u*)(O + (size_t)row * 4096 + hh * 256 + 4 * F.lane); w1[hh] = *(const GAS v2u*)(O + (size_t)row * 4096 + 2048 + hh * 256 + 4 * F.lane); }
#pragma unroll
        for (int hh = 0; hh < 8; ++hh) {
            const float o0 = bf_lo(w0[hh].x) - lmb * bf_lo(w1[hh].x), o1 = bf_hi(w0[hh].x) - lmb * bf_hi(w1[hh].x), o2 = bf_lo(w0[hh].y) - lmb * bf_lo(w1[hh].y), o3 = bf_hi(w0[hh].y) - lmb * bf_hi(w1[hh].y);
            const float ss = wave_sum((o0 * o0 + o1 * o1) + (o2 * o2 + o3 * o3));
            const float r = __builtin_amdgcn_rsqf(ss * (1.f / 256.f) + EPS) * (1.f - linit);
            v2u ow; ow.x = pk2(o0 * r * sgv.x, o1 * r * sgv.y); ow.y = pk2(o2 * r * sgv.z, o3 * r * sgv.w);
            *(GAS v2u*)(ab + (size_t)row * DM + hh * 256 + 4 * F.lane) = ow;
        }
    }
}
__device__ __forceinline__ void rt_combine_phase(Frame& F0, const Args& a) {
    Frame F = F0; F.tid = opaque_tid(F0.wave); F.lane = F.tid & 63;
    bf16* of = (bf16*)(a.ws + WS_OBUF); const bf16* ob = (const bf16*)(a.ws + WS_XBUF); const bf16* proj = (const bf16*)(a.ws + WS_PROJ);
    const float* gn = a.in[17];
    for (int it0 = F.gw; it0 < MROWS * 8; it0 += 2 * F.NGW) {
        v4u wf[2], wb[2], wgf[2], wgb[2]; int rowv[2], colv[2]; bool ok[2];
#pragma unroll
        for (int u = 0; u < 2; ++u) { const int it = it0 + u * F.NGW; ok[u] = it < MROWS * 8; const int itc = ok[u] ? it : it0; rowv[u] = itc >> 3; colv[u] = (itc & 7) * 512 + F.lane * 8;
            wf[u] = *(const GAS v4u*)(of + (size_t)rowv[u] * RT_V + colv[u]); wb[u] = *(const GAS v4u*)(ob + (size_t)rowv[u] * RT_V + colv[u]);
            wgf[u] = *(const GAS v4u*)(proj + (size_t)rowv[u] * RT_N + 8192 + colv[u]); wgb[u] = *(const GAS v4u*)(proj + (size_t)rowv[u] * RT_N + 12288 + colv[u]); }
#pragma unroll
        for (int u = 0; u < 2; ++u) {
            const int row = rowv[u], col = colv[u];
            float xf[8], xb[8], gf[8], gb[8], y[8];
            unpack8(wf[u], xf); unpack8(wb[u], xb); unpack8(wgf[u], gf); unpack8(wgb[u], gb);
            float sf = 0.f, sb = 0.f;
#pragma unroll
            for (int e = 0; e < 8; ++e) { sf += xf[e]; sb += xb[e]; }
            const float muf = wave_sum(sf) * (1.f / 512.f), mub = wave_sum(sb) * (1.f / 512.f);
            float qf = 0.f, qb = 0.f;
#pragma unroll
            for (int e = 0; e < 8; ++e) { xf[e] -= muf; xb[e] -= mub; qf += xf[e] * xf[e]; qb += xb[e] * xb[e]; }
            const float rf = __builtin_amdgcn_rsqf(wave_sum(qf) * (1.f / 512.f) + EPS), rb = __builtin_amdgcn_rsqf(wave_sum(qb) * (1.f / 512.f) + EPS);
#pragma unroll
            for (int e = 0; e < 8; ++e) y[e] = silu_f(gf[e]) * (xf[e] * rf * gn[col + e]) + silu_f(gb[e]) * (xb[e] * rb * gn[RT_V + col + e]);
            v4u ow; ow.x = pk2(y[0], y[1]); ow.y = pk2(y[2], y[3]); ow.z = pk2(y[4], y[5]); ow.w = pk2(y[6], y[7]);
            if (ok[u]) *(GAS v4u*)(of + (size_t)row * RT_V + col) = ow;
        }
    }
}
namespace att {
constexpr int D = 128, QBLK = 32, KVBLK = 64;
constexpr float THR = 8.f;
constexpr size_t SHM_V = KVBLK * D * 2, SHM_K = KVBLK * D * 2, SHM_ATTN = 2 * SHM_V + 2 * SHM_K + NWAVES * 64 * 4;
#define KSWZ(row, colB) ((row) * 256 + ((colB) ^ (((row) & 7) << 4)))
__device__ __forceinline__ int crow(int r, int hi) { return (r & 3) + 8 * (r >> 2) + 4 * hi; }
__device__ __forceinline__ void partialSM(f32x16& p0, f32x16& p1, float& m_reg, float& mn, float& alpha, bool band, int kq0, int qidx, int hi) {
  constexpr float C = 1.4426950408889634f;
  if (band) {
    const int dd = kq0 - qidx + 4 * hi + 128;
#pragma unroll
    for (int r = 0; r < 16; ++r) { const int cr = (r & 3) + 8 * (r >> 2);
      p0[r] = ((unsigned)(dd + cr) > 256u) ? -1e30f : p0[r]; p1[r] = ((unsigned)(dd + cr + 32) > 256u) ? -1e30f : p1[r]; }
  }
  float pmax = p0[0];
#pragma unroll
  for (int r = 1; r < 16; ++r) pmax = fmaxf(pmax, p0[r]);
#pragma unroll
  for (int r = 0; r < 16; ++r) pmax = fmaxf(pmax, p1[r]);
  { auto rr = __builtin_amdgcn_permlane32_swap(__float_as_uint(pmax), __float_as_uint(pmax), false, false);
    pmax = fmaxf(__uint_as_float(rr[0]), __uint_as_float(rr[1])); }
  if (__builtin_expect(__all(pmax - m_reg <= THR), 1)) { mn = m_reg; alpha = 1.f; }
  else { mn = fmaxf(m_reg, pmax); alpha = __builtin_amdgcn_exp2f((m_reg - mn) * C); m_reg = mn; }
  const float mnC = -mn * C;
#pragma unroll
  for (int r = 0; r < 16; ++r) p0[r] = fmaf(p0[r], C, mnC);
#pragma unroll
  for (int r = 0; r < 16; ++r) p1[r] = fmaf(p1[r], C, mnC);
#pragma unroll
  for (int r = 0; r < 16; ++r) p0[r] = __builtin_amdgcn_exp2f(p0[r]);
}
__device__ __forceinline__ void finishSM(f32x16& p0, f32x16& p1, float alpha, float& l_reg, bf16x8& pa0, bf16x8& pa1, bf16x8& pa2, bf16x8& pa3) {
#pragma unroll
  for (int r = 0; r < 16; ++r) p1[r] = __builtin_amdgcn_exp2f(p1[r]);
  float ps = 0;
#pragma unroll
  for (int r = 0; r < 16; ++r) ps += p0[r];
#pragma unroll
  for (int r = 0; r < 16; ++r) ps += p1[r];
  { auto rr = __builtin_amdgcn_permlane32_swap(__float_as_uint(ps), __float_as_uint(ps), false, false);
    ps = __uint_as_float(rr[0]) + __uint_as_float(rr[1]); }
  l_reg = l_reg * alpha + ps;
#define PK4(P, BASE, OUT) do { unsigned a0 = cvtpk(P[BASE + 0], P[BASE + 1]), a1 = cvtpk(P[BASE + 2], P[BASE + 3]);   \
    unsigned b0 = cvtpk(P[BASE + 4], P[BASE + 5]), b1 = cvtpk(P[BASE + 6], P[BASE + 7]);                              \
    auto r0 = __builtin_amdgcn_permlane32_swap(a0, b0, false, false); auto r1 = __builtin_amdgcn_permlane32_swap(a1, b1, false, false); \
    v4u w = {r0[0], r1[0], r0[1], r1[1]}; OUT = *reinterpret_cast<bf16x8*>(&w); } while (0)
  PK4(p0, 0, pa0); PK4(p0, 8, pa1); PK4(p1, 0, pa2); PK4(p1, 8, pa3);
#undef PK4
}
__device__ __forceinline__ void qkt(f32x16& p0, f32x16& p1, const char* Ks, const bf16x8* qr, int r32, int hi) {
  p0 = f32x16{}; p1 = f32x16{};
#pragma unroll
  for (int d0 = 0; d0 < 8; ++d0) { const int cb = (d0 * 16 + hi * 8) * 2;
    bf16x8 b0 = *reinterpret_cast<const bf16x8*>(Ks + KSWZ(r32, cb));
    bf16x8 b1 = *reinterpret_cast<const bf16x8*>(Ks + KSWZ(32 + r32, cb));
    p0 = __builtin_amdgcn_mfma_f32_32x32x16_bf16(b0, qr[d0], p0, 0, 0, 0);
    p1 = __builtin_amdgcn_mfma_f32_32x32x16_bf16(b1, qr[d0], p1, 0, 0, 0); }
}
__device__ __forceinline__ int v_st(int k, int c) { const int kk = (k & ~0xC) | ((k & 4) << 1) | ((k & 8) >> 1); return ((kk >> 3) * 4 + (c >> 5)) * 512 + ((kk & 7) * 32 + (c & 31)) * 2; }
__device__ __forceinline__ int v_rd_base(int lane) { return ((lane & 3) << 3) | (((lane >> 2) & 3) << 6) | (((lane >> 4) & 1) << 5) | (((lane >> 5) & 1) << 8); }
constexpr int v_rd_off(int d0, int ks, int half) { return d0 * 512 + ks * 4096 + half * 2048; }
template <int OFF> __device__ __forceinline__ s16x4 tr_read(int vb) {
  s16x4 r; asm volatile("ds_read_b64_tr_b16 %0, %1 offset:%2" : "=&v"(r) : "v"(vb), "i"(OFF) : "memory"); return r;
}
template <int D0> __device__ __forceinline__ void pv_one(f32x16& od, int vb, bf16x8 pa0, bf16x8 pa1, bf16x8 pa2, bf16x8 pa3) {
  const s16x4 l0 = tr_read<v_rd_off(D0, 0, 0)>(vb), h0 = tr_read<v_rd_off(D0, 0, 1)>(vb), l1 = tr_read<v_rd_off(D0, 1, 0)>(vb), h1 = tr_read<v_rd_off(D0, 1, 1)>(vb);
  const s16x4 l2 = tr_read<v_rd_off(D0, 2, 0)>(vb), h2 = tr_read<v_rd_off(D0, 2, 1)>(vb), l3 = tr_read<v_rd_off(D0, 3, 0)>(vb), h3 = tr_read<v_rd_off(D0, 3, 1)>(vb);
  asm volatile("s_waitcnt lgkmcnt(0)" ::: "memory"); SBAR();
#define PK(L, H) (bf16x8){L[0], L[1], L[2], L[3], H[0], H[1], H[2], H[3]}
  od = __builtin_amdgcn_mfma_f32_32x32x16_bf16(PK(l0, h0), pa0, od, 0, 0, 0);
  od = __builtin_amdgcn_mfma_f32_32x32x16_bf16(PK(l1, h1), pa1, od, 0, 0, 0);
  od = __builtin_amdgcn_mfma_f32_32x32x16_bf16(PK(l2, h2), pa2, od, 0, 0, 0);
  od = __builtin_amdgcn_mfma_f32_32x32x16_bf16(PK(l3, h3), pa3, od, 0, 0, 0);
#undef PK
}
constexpr size_t SHM2_K = 16384, SHM2_V = 32768, SHM_ATTN2 = 2 * SHM2_K + 2 * SHM2_V + NWAVES * 64 * 4;
template <int LDQ, int LDK, int LDO>
__device__ __forceinline__ void attn2_body(const bf16* __restrict__ Qb, const bf16* __restrict__ Kh, const bf16* __restrict__ Vh, bf16* __restrict__ Ob, int NT, char* lds, int wave) {
  const int tid = pg8::tid_of(wave); const int wid = __builtin_amdgcn_readfirstlane(tid >> 6), lane = tid & 63, r32 = lane & 31, hi = lane >> 5;
  char* K_lds = lds; char* V_lds = lds + 2 * SHM2_K;
  LAS unsigned char* ldsl = (LAS unsigned char*)(uintptr_t)(unsigned)(uintptr_t)lds;
  float m_reg = -1e30f, l_reg = 0.f; f32x16 o[8] = {}; bf16x8 qr[8];
  const bf16* Qw = Qb + (long)(wid * QBLK + r32) * LDQ + hi * 8;
#pragma unroll
  for (int d0 = 0; d0 < 8; ++d0) qr[d0] = *reinterpret_cast<const bf16x8*>(Qw + d0 * 16);
  const int koff = (tid >> 4) * LDK + (((tid & 15) ^ ((tid >> 4) & 7)) * 8);
  int voff; { const int kk0 = 8 * (tid >> 7) + ((tid >> 2) & 7), k0 = (kk0 & ~0xC) | ((kk0 & 4) << 1) | ((kk0 & 8) >> 1); voff = k0 * LDK + 32 * ((tid >> 5) & 3) + 8 * (tid & 3); }
  const int vb0 = (int)(uintptr_t)V_lds + v_rd_base(lane);
#define A2_STAGE(j_, b_) do { const bf16* kp = Kh + (long)(j_) * 64 * LDK + koff; const bf16* vp = Vh + (long)(j_) * 64 * LDK + voff; \
    _Pragma("unroll") for (int i = 0; i < 2; ++i) __builtin_amdgcn_global_load_lds((const unsigned*)(kp + (long)i * 32 * LDK), (LAS unsigned*)(ldsl + (b_) * SHM2_K + wid * 1024 + i * 8192), 16, 0, 0); \
    _Pragma("unroll") for (int i = 0; i < 4; ++i) __builtin_amdgcn_global_load_lds((const unsigned*)(vp + (long)(i & 1) * 32 * LDK + (i >> 1) * 128), (LAS unsigned*)(ldsl + 2 * SHM2_K + (b_) * SHM2_V + wid * 1024 + i * 8192), 16, 0, 0); } while (0)
  A2_STAGE(0, 0);
  f32x16 p0, p1; float mn, al; bf16x8 pa0, pa1, pa2, pa3;
  for (int j = 0; j < NT; ++j) {
    const int b = j & 1;
    asm volatile("s_waitcnt vmcnt(0) lgkmcnt(0)\n\ts_barrier" ::: "memory");
    if (j + 1 < NT) A2_STAGE(j + 1, b ^ 1);
    qkt(p0, p1, K_lds + b * SHM2_K, qr, r32, hi);
    partialSM(p0, p1, m_reg, mn, al, false, 0, 0, hi);
    finishSM(p0, p1, al, l_reg, pa0, pa1, pa2, pa3);
    if (__any(al < 1.f)) {
#pragma unroll
      for (int d = 0; d < 8; ++d)
#pragma unroll
        for (int r = 0; r < 16; ++r) o[d][r] *= al; }
    const int vb = vb0 + b * (int)SHM2_V;
    pv_one<0>(o[0], vb, pa0, pa1, pa2, pa3); pv_one<1>(o[1], vb, pa0, pa1, pa2, pa3); pv_one<2>(o[2], vb, pa0, pa1, pa2, pa3); pv_one<3>(o[3], vb, pa0, pa1, pa2, pa3);
    pv_one<0>(o[4], vb + 16384, pa0, pa1, pa2, pa3); pv_one<1>(o[5], vb + 16384, pa0, pa1, pa2, pa3); pv_one<2>(o[6], vb + 16384, pa0, pa1, pa2, pa3); pv_one<3>(o[7], vb + 16384, pa0, pa1, pa2, pa3);
  }
  { const float rl = __builtin_amdgcn_rcpf(l_reg);
    bf16* Ow = Ob + (long)(wid * QBLK + r32) * LDO;
#pragma unroll
    for (int d0 = 0; d0 < 8; ++d0)
#pragma unroll
      for (int g = 0; g < 4; g += 2) {
        const unsigned a0 = pk2(o[d0][4 * g + 0] * rl, o[d0][4 * g + 1] * rl), a1 = pk2(o[d0][4 * g + 2] * rl, o[d0][4 * g + 3] * rl);
        const unsigned b0 = pk2(o[d0][4 * g + 4] * rl, o[d0][4 * g + 5] * rl), b1 = pk2(o[d0][4 * g + 6] * rl, o[d0][4 * g + 7] * rl);
        auto s0 = __builtin_amdgcn_permlane32_swap(a0, b0, false, false); auto s1 = __builtin_amdgcn_permlane32_swap(a1, b1, false, false);
        v4u w = {s0[0], s1[0], s0[1], s1[1]};
        *(v4u*)(Ow + d0 * 32 + 8 * (g + hi)) = w; } }
  asm volatile("s_waitcnt vmcnt(0) lgkmcnt(0)\n\ts_barrier" ::: "memory");
#undef A2_STAGE
}

template <int LDQ, int LDK, int LDO, bool BAND, bool SINK>
__device__ __forceinline__ void attn3_body(const bf16* __restrict__ Qb, const bf16* __restrict__ Kh, const bf16* __restrict__ Vh, bf16* __restrict__ Ob,
                                           int NT, int nctx, int latrow0, int klat0, int q0, float sink, char* lds, int wave) {
  const int tid = pg8::tid_of(wave); const int wid = __builtin_amdgcn_readfirstlane(tid >> 6), lane = tid & 63, r32 = lane & 31, hi = lane >> 5;
  char* K_lds = lds; char* V_lds = lds + 2 * SHM2_K;
  LAS unsigned char* ldsl = (LAS unsigned char*)(uintptr_t)(unsigned)(uintptr_t)lds;
  float m_reg = SINK ? sink : -1e30f, l_reg = SINK ? 1.f : 0.f; f32x16 o[4] = {}; bf16x8 qr[8];
  const bf16* Qw = Qb + (long)(wid * QBLK + r32) * LDQ + hi * 8;
#pragma unroll
  for (int d0 = 0; d0 < 8; ++d0) qr[d0] = *reinterpret_cast<const bf16x8*>(Qw + d0 * 16);
  const int qidx = q0 + wid * QBLK + r32, qlo = q0 + wid * QBLK;
  const int koff = (tid >> 4) * LDK + (((tid & 15) ^ ((tid >> 4) & 7)) * 8);
  int voff; { const int kk0 = 8 * (tid >> 7) + ((tid >> 2) & 7), k0 = (kk0 & ~0xC) | ((kk0 & 4) << 1) | ((kk0 & 8) >> 1); voff = k0 * LDK + 32 * ((tid >> 5) & 3) + 8 * (tid & 3); }
  const int vb0 = (int)(uintptr_t)V_lds + v_rd_base(lane);
#define A3_ROW(j_) ((j_) < nctx ? 64 * (j_) : latrow0 + 64 * ((j_) - nctx))
#define A3_STAGE(j_, b_) do { const long r0_ = A3_ROW(j_); const bf16* kp = Kh + r0_ * LDK + koff; const bf16* vp = Vh + r0_ * LDK + voff; \
    _Pragma("unroll") for (int i = 0; i < 2; ++i) __builtin_amdgcn_global_load_lds((const unsigned*)(kp + (long)i * 32 * LDK), (LAS unsigned*)(ldsl + (b_) * SHM2_K + wid * 1024 + i * 8192), 16, 0, 0); \
    _Pragma("unroll") for (int i = 0; i < 2; ++i) __builtin_amdgcn_global_load_lds((const unsigned*)(vp + (long)i * 32 * LDK), (LAS unsigned*)(ldsl + 2 * SHM2_K + (b_) * SHM2_V + wid * 1024 + i * 8192), 16, 0, 0); } while (0)
  A3_STAGE(0, 0);
  f32x16 p0, p1; float mn, al; bf16x8 pa0, pa1, pa2, pa3;
  for (int j = 0; j < NT; ++j) {
    const int b = j & 1;
    asm volatile("s_waitcnt vmcnt(0) lgkmcnt(0)\n\ts_barrier" ::: "memory");
    if (j + 1 < NT) A3_STAGE(j + 1, b ^ 1);
    const bool band = BAND && j >= nctx; const int kq = klat0 + 64 * (j - nctx);
    if (!band || (kq + 63 >= qlo - 128 && kq <= qlo + QBLK - 1 + 128)) {
      qkt(p0, p1, K_lds + b * SHM2_K, qr, r32, hi);
      partialSM(p0, p1, m_reg, mn, al, band, kq, qidx, hi);
      finishSM(p0, p1, al, l_reg, pa0, pa1, pa2, pa3);
      if (__any(al < 1.f)) {
#pragma unroll
        for (int d = 0; d < 4; ++d)
#pragma unroll
          for (int r = 0; r < 16; ++r) o[d][r] *= al; }
      const int vb = vb0 + b * (int)SHM2_V;
      pv_one<0>(o[0], vb, pa0, pa1, pa2, pa3); pv_one<1>(o[1], vb, pa0, pa1, pa2, pa3); pv_one<2>(o[2], vb, pa0, pa1, pa2, pa3); pv_one<3>(o[3], vb, pa0, pa1, pa2, pa3);
    }
  }
  { const float rl = __builtin_amdgcn_rcpf(l_reg);
    bf16* Ow = Ob + (long)(wid * QBLK + r32) * LDO;
#pragma unroll
    for (int d0 = 0; d0 < 4; ++d0)
#pragma unroll
      for (int g = 0; g < 4; g += 2) {
        const unsigned a0 = pk2(o[d0][4 * g + 0] * rl, o[d0][4 * g + 1] * rl), a1 = pk2(o[d0][4 * g + 2] * rl, o[d0][4 * g + 3] * rl);
        const unsigned b0 = pk2(o[d0][4 * g + 4] * rl, o[d0][4 * g + 5] * rl), b1 = pk2(o[d0][4 * g + 6] * rl, o[d0][4 * g + 7] * rl);
        auto s0 = __builtin_amdgcn_permlane32_swap(a0, b0, false, false); auto s1 = __builtin_amdgcn_permlane32_swap(a1, b1, false, false);
        v4u w = {s0[0], s1[0], s0[1], s1[1]};
        *(v4u*)(Ow + d0 * 32 + 8 * (g + hi)) = w; } }
  asm volatile("s_waitcnt vmcnt(0) lgkmcnt(0)\n\ts_barrier" ::: "memory");
#undef A3_STAGE
#undef A3_ROW
}
}
__device__ __forceinline__ void ga_attn_phase(Frame& F0, const Args& a, int jg, int need_ctx, char* lds) {
    Frame F = F0; F.tid = opaque_tid(F0.wave); F.lane = F.tid & 63;
    const bf16* proj = (const bf16*)(a.ws + WS_PROJ); bf16* ob = (bf16*)(a.ws + WS_OBUF);
    const float* sinkp = a.in[12] + jg * 16;
    const int nlat = NB * 16 * 16, nunits = nlat + (need_ctx ? NB * 16 : 0);
    for (int u = F.bid; u < nunits; u += F.G) {
        int head, b, qrow, nt, latrow0, klat0, q0;
        if (u < nlat) { const int w = u & 255, x = w & 7, i = w >> 3; head = (x >> 1) * 4 + (i & 3); const int qt = (x & 1) * 8 + (i >> 2); b = u >> 8;
            const int ks = (qt * 256 - 128 < 0) ? 0 : qt * 256 - 128, ke = (qt * 256 + 384 > SEQ) ? SEQ : qt * 256 + 384;
            qrow = CTXL + qt * 256; nt = 4 + (ke - ks) / 64; latrow0 = CTXL + ks; klat0 = ks; q0 = qt * 256; }
        else { const int uu = u - nlat; head = uu & 15; b = uu >> 4; qrow = 0; nt = 4; latrow0 = 0; klat0 = 0; q0 = 0; }
        const int kv = head >> 2; const size_t rb = (size_t)b * RPB;
        att::attn3_body<GA_N, GA_N, DM, true, true>(proj + (rb + qrow) * GA_N + head * 128, proj + rb * GA_N + 2048 + kv * 128, proj + rb * GA_N + 2560 + kv * 128,
            ob + (rb + qrow) * DM + head * 128, nt, 4, latrow0, klat0, q0, sinkp[head], lds, F.wave);
    }
}
__device__ __forceinline__ void df_attn_phase(Frame& F0, const Args& a, char* lds) {
    Frame F = F0; F.tid = opaque_tid(F0.wave); F.lane = F.tid & 63;
    const bf16* proj = (const bf16*)(a.ws + WS_PROJ); bf16* ob = (bf16*)(a.ws + WS_OBUF);
    const int nlat = NB * 16 * 16, nunits = nlat + NB * 16;
    for (int u = F.bid; u < nunits; u += F.G) {
        int qt, combo, b, nt; size_t qrow;
        if (u < nlat) { const int w = u & 255, i = w >> 3; qt = i >> 1; combo = (w & 7) * 2 + (i & 1); b = u >> 8; nt = RPB / 64; qrow = (size_t)b * RPB + CTXL + qt * 256; }
        else { const int uu = u - nlat; combo = uu & 15; b = uu >> 4; nt = CTXL / 64; qrow = (size_t)b * RPB; }
        const int hh = combo >> 1, r = combo & 1;
        const size_t rb = (size_t)b * RPB;
        att::attn2_body<DF_N, DF_N, 4096>(proj + qrow * DF_N + (hh * 2 + r) * 128, proj + rb * DF_N + 2048 + (hh * 2 + r) * 128, proj + rb * DF_N + 4096 + hh * 256,
            ob + qrow * 4096 + r * 2048 + hh * 256, nt, lds, F.wave);
    }
}
namespace rt {
__device__ __forceinline__ unsigned off_a(unsigned row, unsigned ch) { return 2048u * (row >> 3) + 512u * (ch >> 2) + 64u * (row & 7) + 16u * ((ch & 3) ^ ((row >> 2) & 3)); }
__device__ __forceinline__ unsigned rr_base(unsigned lane, unsigned e) { return off_a(lane & 31, 2 * e + (lane >> 5)); }
__device__ __forceinline__ unsigned tr_base(unsigned lane, unsigned t) {
    const unsigned h = lane >> 5, blk = (lane >> 4) & 1, q = (lane & 15) >> 2, p = lane & 3;
    return off_a(8 * h + 4 * t + q, 2 * blk + (p >> 1)) + 8 * (p & 1);
}
template <int OFF> __device__ __forceinline__ s16x4 trd(unsigned addr) { s16x4 r; asm volatile("ds_read_b64_tr_b16 %0, %1 offset:%2" : "=&v"(r) : "v"(addr), "i"(OFF) : "memory"); return r; }
template <int OFF> __device__ __forceinline__ bf16x8 rrd(unsigned addr) { bf16x8 r; asm volatile("ds_read_b128 %0, %1 offset:%2" : "=&v"(r) : "v"(addr), "i"(OFF) : "memory"); return r; }
__device__ __forceinline__ int crow(int r, int hi) { return (r & 3) + 8 * (r >> 2) + 4 * hi; }
#define PK8(L, H) (bf16x8){L[0], L[1], L[2], L[3], H[0], H[1], H[2], H[3]}
constexpr int RQ = 0, RK = 32768, RV = 65536, RS = 98304;
template <int SP> __device__ __forceinline__ void mm_rr(f32x16& c0, f32x16& c1, unsigned aE, unsigned aO, unsigned bE, unsigned bO) {
    const bf16x8 a0 = rrd<512 * SP>(aE), a1 = rrd<512 * SP>(aO);
    const bf16x8 b00 = rrd<512 * SP>(bE), b01 = rrd<512 * SP>(bO), b10 = rrd<512 * SP + 8192>(bE), b11 = rrd<512 * SP + 8192>(bO);
    asm volatile("s_waitcnt lgkmcnt(0)" ::: "memory"); SBAR();
    c0 = __builtin_amdgcn_mfma_f32_32x32x16_bf16(a0, b00, c0, 0, 0, 0); c1 = __builtin_amdgcn_mfma_f32_32x32x16_bf16(a0, b10, c1, 0, 0, 0);
    c0 = __builtin_amdgcn_mfma_f32_32x32x16_bf16(a1, b01, c0, 0, 0, 0); c1 = __builtin_amdgcn_mfma_f32_32x32x16_bf16(a1, b11, c1, 0, 0, 0);
    asm volatile("" : "+v"(c0), "+v"(c1));
}
template <int KS> __device__ __forceinline__ void mm_tt(f32x16& c0, f32x16& c1, unsigned aT0, unsigned aT1, unsigned bT0, unsigned bT1) {
    const s16x4 a0 = trd<4096 * KS>(aT0), a1 = trd<4096 * KS>(aT1);
    const s16x4 b00 = trd<4096 * KS>(bT0), b01 = trd<4096 * KS>(bT1), b10 = trd<4096 * KS + 512>(bT0), b11 = trd<4096 * KS + 512>(bT1);
    asm volatile("s_waitcnt lgkmcnt(0)" ::: "memory"); SBAR();
    const bf16x8 af = PK8(a0, a1);
    c0 = __builtin_amdgcn_mfma_f32_32x32x16_bf16(af, PK8(b00, b01), c0, 0, 0, 0); c1 = __builtin_amdgcn_mfma_f32_32x32x16_bf16(af, PK8(b10, b11), c1, 0, 0, 0);
    asm volatile("" : "+v"(c0), "+v"(c1));
}
template <int KS> __device__ __forceinline__ void mm_rt(f32x16& c0, f32x16& c1, unsigned aB, unsigned bT0, unsigned bT1) {
    const bf16x8 a0 = rrd<512 * (KS >> 1)>(aB);
    const s16x4 b00 = trd<4096 * KS>(bT0), b01 = trd<4096 * KS>(bT1), b10 = trd<4096 * KS + 512>(bT0), b11 = trd<4096 * KS + 512>(bT1);
    asm volatile("s_waitcnt lgkmcnt(0)" ::: "memory"); SBAR();
    c0 = __builtin_amdgcn_mfma_f32_32x32x16_bf16(a0, PK8(b00, b01), c0, 0, 0, 0); c1 = __builtin_amdgcn_mfma_f32_32x32x16_bf16(a0, PK8(b10, b11), c1, 0, 0, 0);
    asm volatile("" : "+v"(c0), "+v"(c1));
}
#define RT_BAR(NV) do { if (PROBE & 4) asm volatile("s_waitcnt vmcnt(" #NV ") lgkmcnt(0)" ::: "memory"); else asm volatile("s_waitcnt vmcnt(" #NV ") lgkmcnt(0)\n\ts_barrier" ::: "memory"); } while (0)
#define RT_BARL() do { if (PROBE & 4) asm volatile("s_waitcnt lgkmcnt(0)" ::: "memory"); else asm volatile("s_waitcnt lgkmcnt(0)\n\ts_barrier" ::: "memory"); } while (0)
template <int PROBE> __device__ __forceinline__ void scan_unit(const bf16* __restrict__ proj, const bf16* __restrict__ kbw, bf16* __restrict__ outp, int b, int hh, int dir, int sl, float lg2, unsigned ldsb, char* lds, int wave) {
    const int tid = pg8::tid_of(wave);
    const int wid = __builtin_amdgcn_readfirstlane(tid >> 6), wr = wid >> 1, wc = wid & 1;
    const size_t rb = (size_t)b * RPB;
    const int qcol = hh * 256, vcol = 4096 + hh * 512 + sl * 128, ocol = hh * 512 + sl * 128;
    const bf16* kptr = dir == 0 ? proj + 2048 + hh * 256 : kbw + hh * 256;
    const int ldk = dir == 0 ? RT_N : DM;
    f32x16 S[2][2];
#pragma unroll
    for (int i = 0; i < 2; ++i)
#pragma unroll
        for (int t = 0; t < 2; ++t) S[i][t] = f32x16{};
    const float g128 = exp2f(lg2 * 128.f);
    const unsigned oW = 8192u * wr, oC = 16384u * wc;
    const unsigned cW = 512u * wr, cC = 1024u * wc;
    int dma_off, dma_offk;
    { const int ln = tid & 63, rowb = 8 * (wid >> 1) + ((ln >> 2) & 7), ch = 4 * (2 * (wid & 1) + (ln >> 5)) + ((ln & 3) ^ ((rowb >> 2) & 3)); dma_off = rowb * RT_N + ch * 8; dma_offk = rowb * ldk + ch * 8; }
    LAS unsigned char* ldsl = (LAS unsigned char*)(uintptr_t)ldsb;
#define RT_CHUNK_ROW(ci_) (rb + (size_t)(dir == 0 ? (ci_) : ((ci_) == 0 ? 1 : ((ci_) == 1 ? 0 : 35 - (ci_)))) * 128)
#define RT_DMA(REG, gp_, ld_, off_) if (!(PROBE & 2)) _Pragma("unroll") for (int i = 0; i < 4; ++i) __builtin_amdgcn_global_load_lds((const unsigned*)((gp_) + (size_t)i * 32 * (ld_) + (off_)), (LAS unsigned*)(ldsl + (REG) + wid * 1024 + i * 8192), 16, 0, 0)
#define RT_STORES(hd_) { int tq = tid; asm volatile("" : "+v"(tq)); const int r32_ = tq & 31, hi_ = (tq >> 5) & 1; _Pragma("unroll") for (int t = 0; t < 2; ++t) { const unsigned dv = (2 * wc + t) * 32 + r32_; \
        _Pragma("unroll") for (int g = 0; g < 4; ++g) { v2u w; w.x = cvtpk_s(S[hd_][t][4 * g + 0], S[hd_][t][4 * g + 1]); w.y = cvtpk_s(S[hd_][t][4 * g + 2], S[hd_][t][4 * g + 3]); \
            *(v2u*)(lds + RS + off_a(dv, wr * 4 + g) + 8 * hi_) = w; } } }
#define RT_PO() do { unsigned rE = rE0, rO = rO0; asm volatile("" : "+v"(rE), "+v"(rO)); \
        { const unsigned aE = rE + RK + oW, aO = rO + RK + oW, bE = rE + RQ + oC, bO = rO + RQ + oC; \
          mm_rr<0>(P0, P1, aE, aO, bE, bO); mm_rr<1>(P0, P1, aE, aO, bE, bO); mm_rr<2>(P0, P1, aE, aO, bE, bO); mm_rr<3>(P0, P1, aE, aO, bE, bO); } \
        { const unsigned aE = rE + RQ + oW, aO = rO + RQ + oW, bE = rE + RS + oC, bO = rO + RS + oC; \
          mm_rr<0>(O0, O1, aE, aO, bE, bO); mm_rr<1>(O0, O1, aE, aO, bE, bO); mm_rr<2>(O0, O1, aE, aO, bE, bO); mm_rr<3>(O0, O1, aE, aO, bE, bO); } } while (0)
#define RT_SUPD(hd_) do { unsigned tT0 = tT00, tT1 = tT10; asm volatile("" : "+v"(tT0), "+v"(tT1)); const unsigned a0 = tT0 + RK + cW, a1 = tT1 + RK + cW, b0 = tT0 + RV + cC, b1 = tT1 + RV + cC; \
          mm_tt<0>(S[hd_][0], S[hd_][1], a0, a1, b0, b1); mm_tt<1>(S[hd_][0], S[hd_][1], a0, a1, b0, b1); mm_tt<2>(S[hd_][0], S[hd_][1], a0, a1, b0, b1); mm_tt<3>(S[hd_][0], S[hd_][1], a0, a1, b0, b1); \
          mm_tt<4>(S[hd_][0], S[hd_][1], a0, a1, b0, b1); mm_tt<5>(S[hd_][0], S[hd_][1], a0, a1, b0, b1); mm_tt<6>(S[hd_][0], S[hd_][1], a0, a1, b0, b1); mm_tt<7>(S[hd_][0], S[hd_][1], a0, a1, b0, b1); } while (0)
    { const size_t r0 = RT_CHUNK_ROW(0); RT_DMA(RQ, proj + r0 * RT_N + qcol, RT_N, dma_off); RT_DMA(RK, kptr + r0 * ldk, ldk, dma_offk); }
    for (int ci = 0; ci < 34; ++ci) {
        const size_t row0 = RT_CHUNK_ROW(ci);
        int tz = tid; asm volatile("" : "+v"(tz));
        const int lanez = tz & 63, r32 = lanez & 31, hi = lanez >> 5;
        const unsigned rE0 = ldsb + rr_base(lanez, 0), rO0 = ldsb + rr_base(lanez, 1), tT00 = ldsb + tr_base(lanez, 0), tT10 = ldsb + tr_base(lanez, 1);
        const int ib = wr * 32 + 4 * hi;
#pragma unroll
        for (int i = 0; i < 2; ++i)
#pragma unroll
            for (int t = 0; t < 2; ++t) S[i][t] *= g128;
        const bf16* gbase = proj + row0 * RT_N; const bf16* kbase = kptr + row0 * ldk;
        f32x16 P0 = f32x16{}, P1 = f32x16{}, O0 = f32x16{}, O1 = f32x16{};
        RT_DMA(RV, gbase + vcol, RT_N, dma_off);
        RT_STORES(0);
        RT_BAR(4);
        RT_PO();
        RT_BAR(0);
        RT_DMA(RQ, gbase + qcol + 128, RT_N, dma_off);
        RT_SUPD(0);
        RT_BARL();
        RT_DMA(RK, kbase + 128, ldk, dma_offk);
        RT_STORES(1);
        RT_BAR(0);
        RT_PO();
        RT_BARL();
        if (ci + 1 < 34) { const size_t rn = RT_CHUNK_ROW(ci + 1); RT_DMA(RQ, proj + rn * RT_N + qcol, RT_N, dma_off); }
        RT_SUPD(1);
        RT_BARL();
        if (ci + 1 < 34) { const size_t rn = RT_CHUNK_ROW(ci + 1); RT_DMA(RK, kptr + rn * ldk, ldk, dma_offk); }
#pragma unroll
        for (int t = 0; t < 2; ++t) { const int i = (2 * wc + t) * 32 + r32; int dji = ib - i; if (dir) dji = -dji;
#pragma unroll
            for (int g = 0; g < 4; ++g) { float v[4];
#pragma unroll
                for (int e = 0; e < 4; ++e) { const int je = dir == 0 ? (8 * g + e) : -(8 * g + e); const bool keep = (dji + je) <= 0; const float pv = t == 0 ? P0[4 * g + e] : P1[4 * g + e]; v[e] = keep ? pv : 0.f; }
                v2u w; w.x = cvtpk_s(v[0], v[1]); w.y = cvtpk_s(v[2], v[3]);
                *(v2u*)(lds + RS + off_a(i, wr * 4 + g) + 8 * hi) = w; } }
        RT_BARL();
        { unsigned rE = rE0, rO = rO0, tT0 = tT00, tT1 = tT10; asm volatile("" : "+v"(rE), "+v"(rO), "+v"(tT0), "+v"(tT1));
          const unsigned aE = rE + RS + oW, aO = rO + RS + oW, b0 = tT0 + RV + cC, b1 = tT1 + RV + cC;
          mm_rt<0>(O0, O1, aE, b0, b1); mm_rt<1>(O0, O1, aO, b0, b1); mm_rt<2>(O0, O1, aE, b0, b1); mm_rt<3>(O0, O1, aO, b0, b1);
          mm_rt<4>(O0, O1, aE, b0, b1); mm_rt<5>(O0, O1, aO, b0, b1); mm_rt<6>(O0, O1, aE, b0, b1); mm_rt<7>(O0, O1, aO, b0, b1); }
        GAS bf16* obase = (GAS bf16*)(outp + row0 * RT_V + ocol + (wr * 32 + 4 * hi) * RT_V + wc * 64 + r32); asm volatile("" : "+v"(obase));
#pragma unroll
        for (int r = 0; r < 16; ++r) { const int iz = ib + (r & 3) + 8 * (r >> 2);
            const float mi = __builtin_amdgcn_exp2f(lg2 * (float)(dir == 0 ? iz - 127 : -iz));
            if (PROBE & 1) { asm volatile("" :: "v"(O0[r] * mi), "v"(O1[r] * mi)); } else {
            obase[(r & 3) * RT_V + (r >> 2) * 8 * RT_V] = (bf16)f2bf(O0[r] * mi); obase[(r & 3) * RT_V + (r >> 2) * 8 * RT_V + 32] = (bf16)f2bf(O1[r] * mi); } }
        RT_BARL();
    }
    asm volatile("s_waitcnt vmcnt(0)" ::: "memory");
}
#undef RT_BAR
#undef RT_BARL
#undef RT_CHUNK_ROW
#undef RT_DMA
#undef RT_STORES
#undef RT_PO
#undef RT_SUPD
#undef PK8
}
template <int PROBE> __device__ __forceinline__ void rt_scan_phase(Frame& F0, const Args& a, char* lds) {
    Frame F = F0; F.tid = opaque_tid(F0.wave); F.lane = F.tid & 63;
    const bf16* proj = (const bf16*)(a.ws + WS_PROJ);
    for (int u0 = F.bid; u0 < NB * 8 * 2 * 4; u0 += F.G) {
        const int w_ = u0 & 255, x_ = w_ & 7, i_ = w_ >> 3; const int u = (u0 & ~255) | ((((i_ >> 2) * 8 + x_) << 2) | (i_ & 3));
        const int sl = u & 3, dir = (u >> 2) & 1, hh = (u >> 3) & 7, b = u >> 6;
        const float x = a.in[16][dir * 8 + hh];
        const float lg2 = -log2f(1.f + expf(-x));
        bf16* outp = (bf16*)(a.ws + (dir == 0 ? WS_OBUF : WS_XBUF));
        rt::scan_unit<PROBE>(proj, (const bf16*)a.out  , outp, b, hh, dir, sl, lg2, (unsigned)(uintptr_t)lds, lds, F.wave);
    }
}
constexpr int NPHASE = 42;
#ifndef PHMASK
#define PHMASK 0xffff
#endif
#define EN(k) ((PHMASK >> (k)) & 1)
#ifndef REPMASK
#define REPMASK 0
#endif
#ifndef REPCNT
#define REPCNT 1
#endif
#define NREP(k) (((REPMASK >> (k)) & 1) ? 1 + REPCNT : 1)
#ifndef GEMM_ALIGN
#define GEMM_ALIGN true
#endif
#ifndef GEMM_SP2
#define GEMM_SP2 true
#endif
#ifndef SCANPROBE
#define SCANPROBE 0
#endif
#ifndef MK_PER_PHASE
#define MK_PER_PHASE 0
#endif
#ifndef NVGPR_ATTR
#define NVGPR_ATTR
#endif
#ifndef LB_ATTR
#define LB_ATTR __launch_bounds__(NTHR, 2)
#endif
__global__ void LB_ATTR NVGPR_ATTR mega_fwd(Args args) {
    extern __shared__ __attribute__((aligned(16))) unsigned char lds[];
    Frame F;
    F.lds = (LAS unsigned char*)lds;
    F.MISC = (volatile LAS unsigned*)(F.lds + MISC_OFF);
    F.tid = threadIdx.x; F.lane = F.tid & 63; F.wave = __builtin_amdgcn_readfirstlane(F.tid >> 6);
    F.G = gridDim.x; F.bid = blockIdx.x; F.gw = F.bid * NWAVES + F.wave; F.NGW = F.G * NWAVES;
    unsigned char* ws = args.ws;
    F.ctl = (gu32*)(ws + WS_CTL);
    for (int u = F.tid; u < (LDS_BYTES - RING_BYTES) / 4; u += NTHR) ((LAS unsigned*)(F.lds + RING_BYTES))[u] = 0u;
    __syncthreads();
    XcdBarrier bar; bar.bar = (unsigned*)(F.ctl + CW_BAR); bar.x = 0; bar.st = nullptr; bar.wv = F.wave;
    if (!MK_PER_PHASE) bar = xcd_barrier_post((unsigned*)(F.ctl + CW_BAR), F.MISC + 8);
    const int lo = args.ph_lo, hi = args.ph_hi;
#define IN(k) (lo <= (k) && (k) < hi)
#ifndef BARREP
#define BARREP 1
#endif
#define SEAM(k) do { if (IN(k) && IN((k) + 1)) { for (int br = 0; br < BARREP; ++br) xcd_barrier(bar); } } while (0)
    const float* modbase = (const float*)(ws + WS_MOD);
    pg8::bf16_t* hres = (pg8::bf16_t*)(ws + WS_H);
    bf16* abuf = (bf16*)(ws + WS_ABUF); bf16* proj = (bf16*)(ws + WS_PROJ); bf16* obuf = (bf16*)(ws + WS_OBUF);

    if (IN(0)) { for (int rep = 0; rep < NREP(0); ++rep) p0_prologue(F, args); } SEAM(0);
    if (IN(1)) { if (EN(1)) p0b_modfinal(F, args); } SEAM(1);

#define GEMM_QK(Aptr, Btptr, Nn, Optr, nkt, gqp, gkp, Gq) do { if (EN(3)) for (int rep = 0; rep < NREP(3); ++rep) { pg8::Gemm g{(const pg8::bf16_t*)(Aptr), (const pg8::bf16_t*)(Btptr), MROWS, (Nn), DM}; \
        pg8::StaticOrder S; S.init(68, (Nn), DM, (Gq), F.bid, 0, 0); pg8::EpiQK E{(pg8::bf16_t*)(Optr), (Nn), 8, (nkt), (gqp), (gkp), (const float*)(ws + WS_ROPE), 0.08838834764831845f, (PG8_LAS float*)(F.lds + RING_BYTES + 1024)}; \
        pg8::gemm_phase<pg8::EpiQK, pg8::StaticOrder, GEMM_ALIGN, GEMM_SP2>(F.lds, g, S, E, F.wave); } } while (0)
#define GEMM_RT(Aptr, Btptr, Optr, KBptr) do { if (EN(3)) for (int rep = 0; rep < NREP(3); ++rep) { pg8::Gemm g{(const pg8::bf16_t*)(Aptr), (const pg8::bf16_t*)(Btptr), MROWS, RT_N, DM}; \
        pg8::StaticOrder S; S.init(68, RT_N, DM, F.G, F.bid, 0, 0); pg8::EpiRT E{(pg8::bf16_t*)(Optr), RT_N, (const float*)(ws + WS_ROPE_RT), (pg8::bf16_t*)(KBptr), args.in[16]}; \
        pg8::gemm_phase<pg8::EpiRT, pg8::StaticOrder, GEMM_ALIGN, GEMM_SP2>(F.lds, g, S, E, F.wave); } } while (0)
#define GEMM_FFNIN(Aptr, Btptr, Optr, nMt, latonly, LL) do { if (EN(3)) for (int rep = 0; rep < NREP(3); ++rep) { pg8::Gemm g{(const pg8::bf16_t*)(Aptr), (const pg8::bf16_t*)(Btptr), MROWS, DFF2, DM}; \
        pg8::StaticOrder S; S.init((nMt), DFF2, DM, F.G, F.bid, (latonly), 0); pg8::EpiConvGate E{(pg8::bf16_t*)obuf, (pg8::bf16_t*)(Optr), args.in[8] + (size_t)(LL) * 3 * DFF2, args.in[9] + (size_t)(LL) * DFF2}; \
        pg8::gemm_phase<pg8::EpiConvGate, pg8::StaticOrder, GEMM_ALIGN, GEMM_SP2>(F.lds, g, S, E, F.wave); } } while (0)
#define GEMM_RES(Aptr, Btptr, Kk, gateptr, outptr, nMt, latonly, xsrcp) do { if (EN(11)) for (int rep = 0; rep < NREP(11); ++rep) { pg8::Gemm g{(const pg8::bf16_t*)(Aptr), (const pg8::bf16_t*)(Btptr), MROWS, DM, (Kk)}; \
        pg8::StaticOrder S; S.init(64, DM, (Kk), F.G, F.bid, 1, (nMt) == 68); pg8::EpiResGate E{hres, (gateptr), (outptr), rep ? (float*)(ws + WS_PROJ) : (float*)nullptr, (pg8::bf16_t*)(ws + WS_XBUF), (xsrcp)}; \
        pg8::gemm_phase<pg8::EpiResGate, pg8::StaticOrder, GEMM_ALIGN, GEMM_SP2>(F.lds, g, S, E, F.wave); } } while (0)

#define LAYER(L, KIND, JX, LAST) do { \
    constexpr int PB = 2 + 10 * (L); const float* modl = modbase + (size_t)(L) * 5 * MODW; \
    if (IN(PB + 0)) { for (int rep = 0; rep < NREP(2); ++rep) norm_mod_phase(F, args, (L), 0, 0, (L) > 0 ? modbase + (size_t)((L) - 1) * 5 * MODW + 4 * MODW + 5 * DM : (const float*)nullptr, (L) == 0 ? args.in[0] : (const float*)nullptr, (L) == 0 ? args.in[2] : (const float*)nullptr); } SEAM(PB + 0); \
    if (IN(PB + 1)) { \
        if (KIND == 0) { const int gq_ = ((L) == 0 && F.G == PART_G) ? PART_GEMM : F.G; \
            if (F.bid < gq_) { GEMM_QK(abuf, ws + WS_W_GA_QKV + (size_t)(JX) * GA_N * DM * 2, GA_N, proj, 2, args.in[13] + (JX) * 256, args.in[13] + (JX) * 256 + 128, gq_); \
                if ((L) == 0 && pg8::tid_of(F.wave) == 0) (void)xb_add((unsigned*)F.ctl + CW_DQ_DONE, 1u); } \
            else dq_work(F, args, true); } \
        else if (KIND == 1) GEMM_RT(abuf, ws + WS_W_RT_IN, proj, args.out); \
        else GEMM_QK(abuf, ws + WS_W_DF_QKV, DF_N, proj, 8, args.in[21], args.in[21] + 128, F.G); } SEAM(PB + 1); \
    if (IN(PB + 3)) { \
        if (KIND == 0) { if (EN(6)) for (int rep = 0; rep < NREP(6); ++rep) ga_attn_phase(F, args, (JX), !(LAST), (char*)lds); } \
        else if (KIND == 1) { if (EN(7)) { rt_scan_phase<0>(F, args, (char*)lds); for (int rep = 1; rep < NREP(7); ++rep) rt_scan_phase<SCANPROBE>(F, args, (char*)lds); } } \
        else { if (EN(8)) for (int rep = 0; rep < NREP(8); ++rep) df_attn_phase(F, args, (char*)lds); } } SEAM(PB + 3); \
    if (IN(PB + 4)) { \
        if (KIND == 1) { if (EN(9)) rt_combine_phase(F, args); } \
        else if (KIND == 2) { if (EN(10)) df_combine_phase(F, args, 0.8f - 0.6f * 0.5488116360940264f); } } SEAM(PB + 4); \
    if (IN(PB + 5)) { \
        if (KIND == 0) GEMM_RES(obuf, ws + WS_W_GA_WO + (size_t)(JX) * DM * DM * 2, DM, modl + 2 * DM, (float*)nullptr, (LAST) ? 64 : 68, (LAST), (L) == 0 ? args.in[0] : (const float*)nullptr); \
        else if (KIND == 1) GEMM_RES(obuf, ws + WS_W_RT_WO, RT_V, modl + 2 * DM, (float*)nullptr, 68, 0, (const float*)nullptr); \
        else GEMM_RES(abuf, ws + WS_W_DF_WO, DM, modl + 2 * DM, (float*)nullptr, 68, 0, (const float*)nullptr); } SEAM(PB + 5); \
    if (IN(PB + 6)) { if ((L) == 0) dq_work(F, args, false); for (int rep = 0; rep < NREP(2); ++rep) norm_mod_phase(F, args, (L), 1, (LAST), (LAST) ? (const float*)nullptr : modl + 4 * MODW + 2 * DM, (const float*)nullptr, (L) == 0 ? args.in[2] : (const float*)nullptr); } SEAM(PB + 6); \
    if (IN(PB + 7)) { GEMM_FFNIN(abuf, ws + WS_W_FFN_IN + (size_t)(L) * DFF2 * DM * 2, proj, (LAST) ? 64 : 68, (LAST), (L)); } SEAM(PB + 7); \
    if (IN(PB + 8)) { conv_fix_phase(F, args, (L), (LAST)); } SEAM(PB + 8); \
    if (IN(PB + 9)) { GEMM_RES(obuf, ws + WS_W_FFN_OUT + (size_t)(L) * DM * DFF * 2, DFF, modl + 5 * DM, (LAST) ? args.out : (float*)nullptr, (LAST) ? 64 : 68, (LAST), (const float*)nullptr); } \
    if (!(LAST)) SEAM(PB + 9); \
    } while (0)

    LAYER(0, 0, 0, 0);
    LAYER(1, 1, 0, 0);
    LAYER(2, 2, 0, 0);
    LAYER(3, 0, 1, 1);
#undef IN
#undef SEAM
}

extern "C" void kernel_launch(void* const* d_in, const int* in_sizes, int n_in, void* d_out, int out_size, void* d_ws, size_t ws_size, hipStream_t stream) {
    static int grid = 0;
    if (grid == 0) {
        if (n_in != 24 || in_sizes[0] != NB * SEQ * DM || out_size != NB * SEQ * DM || ws_size < WS_END) {
            fprintf(stderr, "kernel_launch: shape/workspace mismatch: n_in %d in0 %d out %d ws %zu (need %zu); nothing launched\n", n_in, n_in > 0 ? in_sizes[0] : -1, out_size, ws_size, (size_t)WS_END); grid = -1; return; }
        int dev = 0, cus = 0, per_cu = 0;
        if (hipGetDevice(&dev) != hipSuccess || hipDeviceGetAttribute(&cus, hipDeviceAttributeMultiprocessorCount, dev) != hipSuccess) { fprintf(stderr, "kernel_launch: device query failed\n"); grid = -1; return; }
        if (hipFuncSetAttribute((const void*)mega_fwd, hipFuncAttributeMaxDynamicSharedMemorySize, LDS_BYTES) != hipSuccess) { fprintf(stderr, "kernel_launch: hipFuncSetAttribute failed\n"); grid = -1; return; }
        if (hipOccupancyMaxActiveBlocksPerMultiprocessor(&per_cu, (const void*)mega_fwd, NTHR, LDS_BYTES) != hipSuccess || per_cu < 1)
            fprintf(stderr, "kernel_launch: note: occupancy query reports %d workgroups per CU\n", per_cu);
        (void)hipGetLastError();
        grid = cus;
    }
    if (grid < 0) return;
    if (hipMemsetAsync((char*)d_ws + WS_CTL, 0, CTL_ZERO_BYTES, stream) != hipSuccess) { fprintf(stderr, "kernel_launch: memset failed\n"); return; }
    Args a{};
    for (int i = 0; i < 24; ++i) a.in[i] = (const float*)d_in[i];
    a.out = (float*)d_out; a.ws = (unsigned char*)d_ws;
#if MK_PER_PHASE
    for (int p = 0; p < NPHASE; ++p) {
        if (p == 6 || p == 36) continue;
        a.ph_lo = p; a.ph_hi = p + 1;
        hipLaunchKernelGGL(mega_fwd, dim3(grid), dim3(NTHR), LDS_BYTES, stream, a);
    }
#else
    a.ph_lo = 0; a.ph_hi = NPHASE;
    hipLaunchKernelGGL(mega_fwd, dim3(grid), dim3(NTHR), LDS_BYTES, stream, a);
#endif
    const hipError_t le = hipPeekAtLastError();
    if (le != hipSuccess) fprintf(stderr, "kernel_launch: launch failed: %s\n", hipGetErrorName(le));
}
```

```cpp
#include <hip/hip_runtime.h>
#include <hip/hip_bf16.h>
#include <cstdio>
#include <cstdint>
namespace pg8 {
#define PG8_LAS __attribute__((address_space(3)))
typedef unsigned short bf16_t;
typedef short bf16x8 __attribute__((ext_vector_type(8)));
typedef float f32x4 __attribute__((ext_vector_type(4)));
typedef unsigned u32x4 __attribute__((ext_vector_type(4)));
__device__ __forceinline__ int tid_of(int wave) { int t = (wave << 6) | (int)__builtin_amdgcn_mbcnt_hi(~0u, __builtin_amdgcn_mbcnt_lo(~0u, 0u)); asm volatile("" : "+v"(t)); return t; }
constexpr int BM = 256, BK = 64, HALF = 128, HTB = HALF * BK * 2  , STAGE_BYTES = 8 * HTB, NXCD = 8, WGM = 4;

__host__ __device__ __forceinline__ int lds_byte(int r, int c) { const int st = (r >> 4) * 2 + (c >> 5), rr = r & 15, cc = c & 31, ob = rr * 64 + cc * 2; return st * 1024 + (ob ^ (((ob >> 9) & 1) << 5)); }
__host__ __device__ __forceinline__ void stage_rc(int b, int& R, int& C) { const int st = b / 1024, sb = b % 1024, swz = sb ^ (((sb >> 9) & 1) << 5); R = (st >> 1) * 16 + swz / 64; C = (st & 1) * 32 + (swz % 64) / 2; }
__host__ __device__ __forceinline__ int perm32(int rho) { const int n = rho >> 4, i = rho & 15; return 8 * (i >> 2) + 4 * n + (i & 3); }

struct Unit { int pm, pn, k0, nt, aux; };
struct Gemm { const bf16_t* A; const bf16_t* Bt; int M, N, K; };
struct StaticOrder {
    int nM, nN, nwg, G, c, lat_only, ntk, split;
    __host__ __device__ void init(int nM_, int N, int K, int G_, int c_, int lat_only_, int split_) { nM = nM_; nN = N / BM; nwg = nM * nN; G = G_; c = c_; lat_only = lat_only_; ntk = K / BK; split = split_; }
    __host__ __device__ int kslice(int ks) const { return 2 * ((ks * (ntk / 2)) / 8); }
    __host__ __device__ bool next(int i, Unit& u) const {
        const long L = (long)i * G + c;
        if (L >= nwg) {
            if (!split || L >= nwg + 256) return false;
            const int s = (int)(L - nwg), ks = s & 7; u.pm = (s >> 6) * 17; u.pn = (s >> 3) & 7; const int t0 = kslice(ks), t1 = kslice(ks + 1);
            u.k0 = t0 * BK; u.nt = t1 - t0; u.aux = ks; return true;
        }
        u.k0 = 0; u.nt = ntk; u.aux = -1;
        int wgid = (int)L; { const int q = nwg / NXCD, r = nwg % NXCD, xcd = wgid % NXCD, off = wgid / NXCD; wgid = (xcd < r ? xcd * (q + 1) : r * (q + 1) + (xcd - r) * q) + off; }
        const int nig = WGM * nN, gid = wgid / nig, fm = gid * WGM, gsz = (nM - fm) < WGM ? (nM - fm) : WGM;
        int pm = fm + ((wgid % nig) % gsz); u.pn = (wgid % nig) / gsz;
        if (lat_only) pm = (pm >> 4) * 17 + 1 + (pm & 15);
        u.pm = pm; return true;
    }
    __device__ __forceinline__ void a_ready(const Unit&) const {}
    __device__ __forceinline__ void done(const Unit&) const {}
};

__device__ __forceinline__ unsigned cvt_pk_bf16(float lo, float hi) { unsigned r; asm volatile("v_cvt_pk_bf16_f32 %0, %1, %2" : "=v"(r) : "v"(lo), "v"(hi)); return r; }
typedef _Float16 f16x2_t __attribute__((ext_vector_type(2)));
__device__ __forceinline__ unsigned pk2h(float lo, float hi) { f16x2_t v = {(_Float16)lo, (_Float16)hi}; return __builtin_bit_cast(unsigned, v); }
__device__ __forceinline__ float h_lo(unsigned w) { return (float)__builtin_bit_cast(f16x2_t, w).x; }
__device__ __forceinline__ float h_hi(unsigned w) { return (float)__builtin_bit_cast(f16x2_t, w).y; }

__device__ __forceinline__ float dpp_prev_lane(float x) { return __builtin_bit_cast(float, __builtin_amdgcn_update_dpp(0, __builtin_bit_cast(int, x), 0x111, 0xf, 0xf, true)); }
__device__ __forceinline__ float dpp_next_lane(float x) { return __builtin_bit_cast(float, __builtin_amdgcn_update_dpp(0, __builtin_bit_cast(int, x), 0x101, 0xf, 0xf, true)); }
struct EpiConvGate {
    static constexpr bool PERM = true, AFTER_DRAIN = false, AROWPERM = true;
    bf16_t* G; bf16_t* EDGE; const float* cw; const float* cb;
    __device__ __forceinline__ void operator()(const f32x4 (&acc)[2][2][4][2], const Unit& u, int wr, int wc, int fr, int fq) const {
        const int row0 = u.pm * BM + wr * 64 + 4 * fr; const int ch0 = u.pn * HALF + wc * 32 + 8 * fq;
        typedef unsigned u32x2 __attribute__((ext_vector_type(2)));
#pragma unroll
        for (int ai = 0; ai < 2; ++ai) {
            u32x2 wlo[4];
#pragma unroll
            for (int n = 0; n < 2; ++n) {
                f32x4 wa[3], wb[3];
#pragma unroll
                for (int t = 0; t < 3; ++t) { wa[t] = *(const f32x4*)(cw + t * 11264 + ch0 + 4 * n); wb[t] = *(const f32x4*)(cw + t * 11264 + 5632 + ch0 + 4 * n); }
                const f32x4 ba = *(const f32x4*)(cb + ch0 + 4 * n), bb = *(const f32x4*)(cb + 5632 + ch0 + 4 * n);
                f32x4 ap, an, bp, bn;
#pragma unroll
                for (int e2 = 0; e2 < 4; ++e2) { ap[e2] = dpp_prev_lane(acc[ai][0][3][n][e2]); an[e2] = dpp_next_lane(acc[ai][0][0][n][e2]); bp[e2] = dpp_prev_lane(acc[ai][1][3][n][e2]); bn[e2] = dpp_next_lane(acc[ai][1][0][n][e2]); }
#pragma unroll
                for (int m = 0; m < 4; ++m) {
                    const f32x4 a0 = m == 0 ? ap : acc[ai][0][m == 0 ? 0 : m - 1][n], a1 = acc[ai][0][m][n], a2 = m == 3 ? an : acc[ai][0][m == 3 ? 3 : m + 1][n];
                    const f32x4 b0 = m == 0 ? bp : acc[ai][1][m - 1 < 0 ? 0 : m - 1][n], b1 = acc[ai][1][m][n], b2 = m == 3 ? bn : acc[ai][1][m == 3 ? 3 : m + 1][n];
                    const f32x4 va = ba + wa[0] * a0 + wa[1] * a1 + wa[2] * a2, vb = bb + wb[0] * b0 + wb[1] * b1 + wb[2] * b2;
                    float gq[4];
#pragma unroll
                    for (int e2 = 0; e2 < 4; ++e2) gq[e2] = va[e2] * __builtin_amdgcn_rcpf(1.f + __builtin_amdgcn_exp2f(-1.4426950408889634f * va[e2])) * vb[e2];
                    u32x2 w; w.x = cvt_pk_bf16(gq[0], gq[1]); w.y = cvt_pk_bf16(gq[2], gq[3]);
                    if (n == 0) wlo[m] = w;
                    else { u32x4 w4; w4.x = wlo[m].x; w4.y = wlo[m].y; w4.z = w.x; w4.w = w.y; *(u32x4*)(G + (size_t)(row0 + ai * HALF + m) * 5632 + ch0) = w4; } }
            }
        }
#pragma unroll
        for (int ai = 0; ai < 2; ++ai) {
            if (fr == 0 || fr == 15) {
                const int run = u.pm * 4 + ai * 2 + wr; const int m0 = fr == 0 ? 0 : 2;
#pragma unroll
                for (int mm = 0; mm < 2; ++mm) { const int m = m0 + mm; bf16_t* ep = EDGE + ((size_t)run * 4 + m) * 11264 + ch0;
#pragma unroll
                    for (int bj = 0; bj < 2; ++bj) { const f32x4 v0 = fr == 0 ? acc[ai][bj][mm][0] : acc[ai][bj][2 + mm][0], v1 = fr == 0 ? acc[ai][bj][mm][1] : acc[ai][bj][2 + mm][1];
                        u32x4 w; w.x = cvt_pk_bf16(v0[0], v0[1]); w.y = cvt_pk_bf16(v0[2], v0[3]); w.z = cvt_pk_bf16(v1[0], v1[1]); w.w = cvt_pk_bf16(v1[2], v1[3]);
                        *(u32x4*)(ep + bj * 5632) = w; } }
            }
        }
    }
};
struct EpiQK {
    static constexpr bool PERM = true, AFTER_DRAIN = false, AROWPERM = false;
    bf16_t* O; int ldc; int nq, nk;
    const float* gq; const float* gk;
    const float* rope;
    float qscale; PG8_LAS float* xch;
    __device__ __forceinline__ void operator()(const f32x4 (&acc)[2][2][4][2], const Unit& u, int wr, int wc, int fr, int fq) const {
        const int row0 = u.pm * BM + wr * 64 + fr; const int col0 = u.pn * BM + wc * 32 + 8 * fq;
        if (u.pn >= nq + nk) {
#pragma unroll
            for (int ai = 0; ai < 2; ++ai)
#pragma unroll
                for (int m = 0; m < 4; ++m) { bf16_t* rowp = O + (size_t)(row0 + ai * HALF + m * 16) * ldc + col0;
#pragma unroll
                    for (int bj = 0; bj < 2; ++bj) { const f32x4 v0 = acc[ai][bj][m][0], v1 = acc[ai][bj][m][1];
                        u32x4 w; w.x = cvt_pk_bf16(v0[0], v0[1]); w.y = cvt_pk_bf16(v0[2], v0[3]); w.z = cvt_pk_bf16(v1[0], v1[1]); w.w = cvt_pk_bf16(v1[2], v1[3]);
                        *(u32x4*)(rowp + bj * HALF) = w; } }
            return;
        }
        const bool isq = u.pn < nq;
#pragma unroll
        for (int ai = 0; ai < 2; ++ai)
#pragma unroll
            for (int m = 0; m < 4; ++m)
#pragma unroll
                for (int bj = 0; bj < 2; ++bj) { const f32x4 v0 = acc[ai][bj][m][0], v1 = acc[ai][bj][m][1];
                    float s = (v0[0] * v0[0] + v0[1] * v0[1]) + (v0[2] * v0[2] + v0[3] * v0[3]) + (v1[0] * v1[0] + v1[1] * v1[1]) + (v1[2] * v1[2] + v1[3] * v1[3]);
                    { auto r_ = __builtin_amdgcn_permlane16_swap(__float_as_uint(s), __float_as_uint(s), false, false); s = __uint_as_float(r_[0]) + __uint_as_float(r_[1]); }
                    { auto r_ = __builtin_amdgcn_permlane32_swap(__float_as_uint(s), __float_as_uint(s), false, false); s = __uint_as_float(r_[0]) + __uint_as_float(r_[1]); }
                    if (fq == 0) xch[(bj * 256 + ai * HALF + wr * 64 + m * 16 + fr) * 4 + wc] = s; }
        asm volatile("s_waitcnt lgkmcnt(0)" ::: "memory"); __builtin_amdgcn_s_barrier(); asm volatile("" ::: "memory");
        const int d0 = 16 * wc + 4 * fq; const float* gp = isq ? gq : gk;
        const f32x4 g1 = *(const f32x4*)(gp + d0), g2 = *(const f32x4*)(gp + 64 + d0);
        const int jt = u.pm % 17; const bool lat = jt != 0; const int t0 = (jt - 1) * 256 + wr * 64 + fr;
#pragma unroll
        for (int ai = 0; ai < 2; ++ai)
#pragma unroll
            for (int m = 0; m < 4; ++m) { const int rl = ai * HALF + wr * 64 + m * 16 + fr; bf16_t* rowp = O + (size_t)(row0 + ai * HALF + m * 16) * ldc + col0;
                f32x4 cs = (f32x4){1.f, 1.f, 1.f, 1.f}, sn = (f32x4){0.f, 0.f, 0.f, 0.f};
                if (lat && rope != nullptr) { const float* rp = rope + (size_t)(t0 + ai * HALF + m * 16) * 128 + d0; cs = *(const f32x4*)rp; sn = *(const f32x4*)(rp + 64); }
#pragma unroll
                for (int bj = 0; bj < 2; ++bj) { const f32x4 p = *(const PG8_LAS f32x4*)(xch + (bj * 256 + rl) * 4);
                    const float r = __builtin_amdgcn_rsqf(((p[0] + p[1]) + (p[2] + p[3])) * (1.f / 128.f) + 1e-6f) * (isq ? qscale : 1.f);
                    const f32x4 v0 = acc[ai][bj][m][0], v1 = acc[ai][bj][m][1];
                    const float a0 = v0[0] * r * g1[0], b0 = v0[1] * r * g2[0], a1 = v0[2] * r * g1[1], b1 = v0[3] * r * g2[1];
                    const float a2 = v1[0] * r * g1[2], b2 = v1[1] * r * g2[2], a3 = v1[2] * r * g1[3], b3 = v1[3] * r * g2[3];
                    u32x4 w;
                    w.x = cvt_pk_bf16(a0 * cs[0] - b0 * sn[0], a0 * sn[0] + b0 * cs[0]); w.y = cvt_pk_bf16(a1 * cs[1] - b1 * sn[1], a1 * sn[1] + b1 * cs[1]);
                    w.z = cvt_pk_bf16(a2 * cs[2] - b2 * sn[2], a2 * sn[2] + b2 * cs[2]); w.w = cvt_pk_bf16(a3 * cs[3] - b3 * sn[3], a3 * sn[3] + b3 * cs[3]);
                    *(u32x4*)(rowp + bj * HALF) = w; } }
    }
};
struct EpiRT {
    static constexpr bool PERM = true, AFTER_DRAIN = false, AROWPERM = false;
    bf16_t* O; int ldc; const float* rope;   bf16_t* KB; const float* decay;
    __device__ __forceinline__ void operator()(const f32x4 (&acc)[2][2][4][2], const Unit& u, int wr, int wc, int fr, int fq) const {
        const int row0 = u.pm * BM + wr * 64 + fr; const int col0 = u.pn * BM + wc * 32 + 8 * fq;
        if (u.pn >= 16) {
#pragma unroll
            for (int ai = 0; ai < 2; ++ai)
#pragma unroll
                for (int m = 0; m < 4; ++m) { bf16_t* rowp = O + (size_t)(row0 + ai * HALF + m * 16) * ldc + col0;
#pragma unroll
                    for (int bj = 0; bj < 2; ++bj) { const f32x4 v0 = acc[ai][bj][m][0], v1 = acc[ai][bj][m][1];
                        u32x4 w; w.x = cvt_pk_bf16(v0[0], v0[1]); w.y = cvt_pk_bf16(v0[2], v0[3]); w.z = cvt_pk_bf16(v1[0], v1[1]); w.w = cvt_pk_bf16(v1[2], v1[3]);
                        __builtin_nontemporal_store(w, (u32x4*)(rowp + bj * HALF)); } }
            return;
        }
        const bool isq = u.pn < 8; const int head = u.pn & 7;
        const float lgf = -__builtin_log2f(1.f + __builtin_expf(-decay[head])), lgb = -__builtin_log2f(1.f + __builtin_expf(-decay[8 + head]));
        const int jt = u.pm % 17; const bool lat = jt != 0; const int t0 = (jt - 1) * 256 + wr * 64 + fr;
        const int dbase = 16 * wc + 4 * fq;
#pragma unroll
        for (int ai = 0; ai < 2; ++ai)
#pragma unroll
            for (int m = 0; m < 4; ++m) { const int row = row0 + ai * HALF + m * 16; const int jc = row & 127;
                bf16_t* rowp = O + (size_t)row * ldc + col0; bf16_t* kbp = KB + (size_t)row * 2048 + head * 256 + wc * 32 + 8 * fq;
                const float s1 = isq ? 0.0625f : __builtin_amdgcn_exp2f(lgf * (float)(127 - jc)), s2 = __builtin_amdgcn_exp2f(lgb * (float)jc);
#pragma unroll
                for (int bj = 0; bj < 2; ++bj) {
                    f32x4 cs = (f32x4){1.f, 1.f, 1.f, 1.f}, sn = (f32x4){0.f, 0.f, 0.f, 0.f};
                    if (lat) { const float* rp = rope + (size_t)(t0 + ai * HALF + m * 16) * 256 + 64 * bj + dbase; cs = *(const f32x4*)rp; sn = *(const f32x4*)(rp + 128); }
                    const f32x4 v0 = acc[ai][bj][m][0], v1 = acc[ai][bj][m][1];
                    const float x0 = v0[0] * cs[0] - v0[1] * sn[0], y0 = v0[0] * sn[0] + v0[1] * cs[0], x1 = v0[2] * cs[1] - v0[3] * sn[1], y1 = v0[2] * sn[1] + v0[3] * cs[1];
                    const float x2 = v1[0] * cs[2] - v1[1] * sn[2], y2 = v1[0] * sn[2] + v1[1] * cs[2], x3 = v1[2] * cs[3] - v1[3] * sn[3], y3 = v1[2] * sn[3] + v1[3] * cs[3];
                    u32x4 w; w.x = cvt_pk_bf16(x0 * s1, y0 * s1); w.y = cvt_pk_bf16(x1 * s1, y1 * s1); w.z = cvt_pk_bf16(x2 * s1, y2 * s1); w.w = cvt_pk_bf16(x3 * s1, y3 * s1);
                    __builtin_nontemporal_store(w, (u32x4*)(rowp + bj * HALF));
                    if (!isq) { u32x4 wb; wb.x = cvt_pk_bf16(x0 * s2, y0 * s2); wb.y = cvt_pk_bf16(x1 * s2, y1 * s2); wb.z = cvt_pk_bf16(x2 * s2, y2 * s2); wb.w = cvt_pk_bf16(x3 * s2, y3 * s2);
                        __builtin_nontemporal_store(wb, (u32x4*)(kbp + bj * HALF)); }
                } }
    }
};
struct EpiResGate {
    static constexpr bool PERM = true, AFTER_DRAIN = false, AROWPERM = false;
    bf16_t* h;   const float* gate;   float* out; float* dry;   bf16_t* part;   const float* xsrc;
    __device__ __forceinline__ void operator()(const f32x4 (&acc)[2][2][4][2], const Unit& u, int wr, int wc, int fr, int fq) const {
        const int b = u.pm / 17, j = u.pm - b * 17; const int v = (j == 0) ? 4 : b;
        const int row0 = u.pm * BM + wr * 64 + fr, col0 = u.pn * BM + wc * 32 + 8 * fq;
        if (u.aux >= 0) {
            bf16_t* pp = part + ((size_t)u.aux * 1024 + b * 256 + wr * 64 + fr) * 2048 + col0;
#pragma unroll
            for (int ai = 0; ai < 2; ++ai)
#pragma unroll
                for (int m = 0; m < 4; ++m)
#pragma unroll
                    for (int bj = 0; bj < 2; ++bj) { const f32x4 y0 = acc[ai][bj][m][0], y1 = acc[ai][bj][m][1];
                        u32x4 w; w.x = pk2h(y0.x, y0.y); w.y = pk2h(y0.z, y0.w); w.z = pk2h(y1.x, y1.y); w.w = pk2h(y1.z, y1.w);
                        *(u32x4*)(pp + (size_t)(ai * HALF + m * 16) * 2048 + bj * HALF) = w; }
            return;
        }
        const float* g = gate + (size_t)v * 12288;
        f32x4 gv[2][2];
#pragma unroll
        for (int bj = 0; bj < 2; ++bj)
#pragma unroll
            for (int n = 0; n < 2; ++n) gv[bj][n] = *(const f32x4*)(g + col0 + bj * HALF + n * 4);
        float* dst = nullptr; long roff = 0;
        if (dry != nullptr) { dst = dry; } else if (out != nullptr) { dst = out; roff = (long)b * 4096 - 256 - (long)b * 4352; }
#pragma unroll
        for (int ai = 0; ai < 2; ++ai) {
            if (xsrc != nullptr) {
                f32x4 x[4][2][2];
#pragma unroll
                for (int m = 0; m < 4; ++m) { const long r = row0 + ai * HALF + m * 16; const float* src = xsrc + (size_t)(r + (long)b * 4096 - 256 - (long)b * 4352) * 2048 + col0;
#pragma unroll
                    for (int bj = 0; bj < 2; ++bj)
#pragma unroll
                        for (int n = 0; n < 2; ++n) x[m][bj][n] = *(const f32x4*)(src + bj * HALF + n * 4); }
#pragma unroll
                for (int m = 0; m < 4; ++m) { const long r = row0 + ai * HALF + m * 16; bf16_t* hp = h + (size_t)r * 2048 + col0;
#pragma unroll
                    for (int bj = 0; bj < 2; ++bj) { const f32x4 y0 = x[m][bj][0] + gv[bj][0] * acc[ai][bj][m][0], y1 = x[m][bj][1] + gv[bj][1] * acc[ai][bj][m][1];
                        if (dst != nullptr) { float* dp = dst + (size_t)(r + roff) * 2048 + col0 + bj * HALF; *(f32x4*)dp = y0; *(f32x4*)(dp + 4) = y1; }
                        else { u32x4 w; w.x = pk2h(y0.x, y0.y); w.y = pk2h(y0.z, y0.w); w.z = pk2h(y1.x, y1.y); w.w = pk2h(y1.z, y1.w); *(u32x4*)(hp + bj * HALF) = w; } } }
            } else {
                u32x4 x[4][2];
#pragma unroll
                for (int m = 0; m < 4; ++m) { const long r = row0 + ai * HALF + m * 16; const bf16_t* src = h + (size_t)r * 2048 + col0;
#pragma unroll
                    for (int bj = 0; bj < 2; ++bj) x[m][bj] = *(const u32x4*)(src + bj * HALF); }
#pragma unroll
                for (int m = 0; m < 4; ++m) { const long r = row0 + ai * HALF + m * 16; bf16_t* hp = h + (size_t)r * 2048 + col0;
#pragma unroll
                    for (int bj = 0; bj < 2; ++bj) { const u32x4 xw = x[m][bj];
                        const f32x4 y0 = (f32x4){h_lo(xw.x), h_hi(xw.x), h_lo(xw.y), h_hi(xw.y)} + gv[bj][0] * acc[ai][bj][m][0];
                        const f32x4 y1 = (f32x4){h_lo(xw.z), h_hi(xw.z), h_lo(xw.w), h_hi(xw.w)} + gv[bj][1] * acc[ai][bj][m][1];
                        if (dst != nullptr) { float* dp = dst + (size_t)(r + roff) * 2048 + col0 + bj * HALF; *(f32x4*)dp = y0; *(f32x4*)(dp + 4) = y1; }
                        else { u32x4 w; w.x = pk2h(y0.x, y0.y); w.y = pk2h(y0.z, y0.w); w.z = pk2h(y1.x, y1.y); w.w = pk2h(y1.z, y1.w); *(u32x4*)(hp + bj * HALF) = w; } } }
            }
        }
    }
};
template <class Epi, class Sched, bool ALIGN_EPI = false, bool SP2 = false>
__device__ __forceinline__ void gemm_phase(PG8_LAS unsigned char* lds, const Gemm g, const Sched& S, const Epi& E, int wave) {
    const int tid = tid_of(wave); const int wid = __builtin_amdgcn_readfirstlane(tid >> 6), lane = tid & 63, wr = wid >> 2, wc = wid & 3, fr = lane & 15, fq = lane >> 4;
    const int K = g.K;
    unsigned voffA[2], voffB[2];
#pragma unroll
    for (int i = 0; i < 2; ++i) { int R, C; stage_rc(tid * 16 + i * 8192, R, C); const int Rb = Epi::PERM ? ((R & ~31) + perm32(R & 31)) : R;
        const int Ra = Epi::AROWPERM ? ((R & 64) + 4 * (R & 15) + ((R >> 4) & 3)) : R;
        voffA[i] = (unsigned)(Ra * K + C) * 2u; voffB[i] = (unsigned)(Rb * K + C) * 2u; }
    const size_t kstep = (size_t)(BK * 2);
    const size_t hstep = (size_t)HALF * K * 2;
    const size_t tstep = 2 * hstep;
    const unsigned ldsw = (unsigned)wid * 1024u;
    const int aoff = lds_byte(wr * 64 + fr, fq * 8), boff = lds_byte(wc * 32 + fr, fq * 8);
#define PG8_SA(b, h) (((b) * 2 + (h)) * HTB)
#define PG8_SB(b, h) ((4 + (b) * 2 + (h)) * HTB)
#define PG8_STAGE(bufoff, gbase, voff) do { _Pragma("unroll") for (int _i = 0; _i < 2; ++_i) \
        __builtin_amdgcn_global_load_lds((const unsigned*)((const char*)(gbase) + (voff)[_i]), (PG8_LAS unsigned*)(lds + (bufoff) + ldsw + _i * 8192), 16, 0, 0); } while (0)
#define PG8_LDA(dst, b, h) do { _Pragma("unroll") for (int m = 0; m < 4; ++m) _Pragma("unroll") for (int k = 0; k < 2; ++k) dst[m][k] = *(const PG8_LAS bf16x8*)(lds + PG8_SA(b, h) + aoff + m * 2048 + k * 1024); } while (0)
#define PG8_LDB(dst, b, h) do { _Pragma("unroll") for (int n = 0; n < 2; ++n) _Pragma("unroll") for (int k = 0; k < 2; ++k) dst[n][k] = *(const PG8_LAS bf16x8*)(lds + PG8_SB(b, h) + boff + n * 2048 + k * 1024); } while (0)
#define PG8_MMA(ai, bj, At, Bt) do { __builtin_amdgcn_s_setprio(1); _Pragma("unroll") for (int m = 0; m < 4; ++m) _Pragma("unroll") for (int n = 0; n < 2; ++n) _Pragma("unroll") for (int k = 0; k < 2; ++k) \
        acc[ai][bj][m][n] = __builtin_amdgcn_mfma_f32_16x16x32_bf16(Bt[n][k], At[m][k], acc[ai][bj][m][n], 0, 0, 0); __builtin_amdgcn_s_setprio(0); } while (0)
#define PG8_WAIT_V(n) asm volatile("s_waitcnt vmcnt(" #n ")" ::: "memory")
#define PG8_WAIT_L(n) asm volatile("s_waitcnt lgkmcnt(" #n ")" ::: "memory")
#define PG8_BAR __builtin_amdgcn_s_barrier()
#define PG8_SCHED __builtin_amdgcn_sched_barrier(0)
    Unit cur, nxt; int ui = 0;
    if (!S.next(0, cur)) return;
    f32x4 acc[2][2][4][2];
#pragma unroll
    for (int a = 0; a < 2; ++a)
#pragma unroll
        for (int b = 0; b < 2; ++b)
#pragma unroll
            for (int m = 0; m < 4; ++m)
#pragma unroll
                for (int n = 0; n < 2; ++n) acc[a][b][m][n] = (f32x4){0.f, 0.f, 0.f, 0.f};
    bf16x8 At[4][2], B0[2][2], B1[2][2];
    const char* cA = (const char*)g.A + (size_t)cur.pm * tstep + (size_t)cur.k0 * 2; const char* cB = (const char*)g.Bt + (size_t)cur.pn * tstep + (size_t)cur.k0 * 2;
    S.a_ready(cur);
    if constexpr (SP2) {
        PG8_STAGE(PG8_SB(0, 0), cB, voffB); PG8_STAGE(PG8_SB(0, 1), cB + hstep, voffB); PG8_STAGE(PG8_SA(0, 0), cA, voffA); PG8_STAGE(PG8_SA(0, 1), cA + hstep, voffA);
        if (wr == 1) PG8_BAR;
        PG8_WAIT_V(2); PG8_BAR;
        PG8_STAGE(PG8_SB(1, 0), cB + kstep, voffB); PG8_STAGE(PG8_SA(1, 0), cA + kstep, voffA); PG8_STAGE(PG8_SB(1, 1), cB + hstep + kstep, voffB);
        PG8_WAIT_V(6); PG8_BAR;
    } else {
        PG8_STAGE(PG8_SB(0, 0), cB, voffB); PG8_STAGE(PG8_SA(0, 0), cA, voffA); PG8_STAGE(PG8_SB(0, 1), cB + hstep, voffB); PG8_STAGE(PG8_SA(0, 1), cA + hstep, voffA);
        if (wr == 1) PG8_BAR;
        PG8_WAIT_V(4); PG8_BAR;
        PG8_STAGE(PG8_SB(1, 0), cB + kstep, voffB); PG8_STAGE(PG8_SA(1, 0), cA + kstep, voffA); PG8_STAGE(PG8_SB(1, 1), cB + hstep + kstep, voffB);
        PG8_WAIT_V(6); PG8_BAR;
    }
    for (;;) {
        const bool has_next = S.next(ui + 1, nxt);
        const char* nA = has_next ? (const char*)g.A + (size_t)nxt.pm * tstep + (size_t)nxt.k0 * 2 : cA; const char* nB = has_next ? (const char*)g.Bt + (size_t)nxt.pn * tstep + (size_t)nxt.k0 * 2 : cB;
        const int nt = cur.nt;
        for (int t = 0; t < nt; t += 2) {
            const bool last = (t == nt - 2);
            const char* a1 = cA + (size_t)(t + 1) * kstep;
            const char* a2 = last ? nA : cA + (size_t)(t + 2) * kstep; const char* b2 = last ? nB : cB + (size_t)(t + 2) * kstep;
            const char* a3 = a2 + kstep; const char* b3 = b2 + kstep;
            if (last && has_next) S.a_ready(nxt);
            if constexpr (SP2) {
            PG8_LDB(B0, 0, 0); PG8_LDB(B1, 0, 1); PG8_SCHED; PG8_LDA(At, 0, 0); PG8_STAGE(PG8_SA(1, 1), a1 + hstep, voffA);
            PG8_WAIT_V(8); PG8_WAIT_L(0); PG8_BAR; PG8_MMA(0, 0, At, B0); PG8_MMA(0, 1, At, B1); PG8_BAR; PG8_SCHED;
            PG8_LDA(At, 0, 1); PG8_STAGE(PG8_SB(0, 0), b2, voffB); PG8_STAGE(PG8_SB(0, 1), b2 + hstep, voffB); PG8_STAGE(PG8_SA(0, 0), a2, voffA);
            PG8_WAIT_V(8); PG8_WAIT_L(0); PG8_BAR; PG8_MMA(1, 0, At, B0); PG8_MMA(1, 1, At, B1); PG8_BAR; PG8_SCHED;
            PG8_LDB(B0, 1, 0); PG8_LDB(B1, 1, 1); PG8_SCHED; PG8_LDA(At, 1, 0); PG8_STAGE(PG8_SA(0, 1), a2 + hstep, voffA);
            PG8_WAIT_V(8); PG8_WAIT_L(0); PG8_BAR; PG8_MMA(0, 0, At, B0); PG8_MMA(0, 1, At, B1); PG8_BAR; PG8_SCHED;
            PG8_LDA(At, 1, 1); PG8_STAGE(PG8_SB(1, 0), b3, voffB); PG8_STAGE(PG8_SB(1, 1), b3 + hstep, voffB); PG8_STAGE(PG8_SA(1, 0), a3, voffA);
            PG8_WAIT_V(8); PG8_WAIT_L(0); PG8_BAR; PG8_MMA(1, 0, At, B0); PG8_MMA(1, 1, At, B1); PG8_BAR; PG8_SCHED;
            } else {
            PG8_LDB(B0, 0, 0); PG8_SCHED; PG8_LDA(At, 0, 0); PG8_STAGE(PG8_SA(1, 1), a1 + hstep, voffA);
            PG8_WAIT_L(8); PG8_BAR; PG8_WAIT_L(0); PG8_MMA(0, 0, At, B0); PG8_BAR; PG8_SCHED;
            PG8_LDB(B1, 0, 1); PG8_STAGE(PG8_SB(0, 0), b2, voffB);
            PG8_BAR; PG8_WAIT_L(0); PG8_MMA(0, 1, At, B1); PG8_BAR;
            PG8_LDA(At, 0, 1); PG8_STAGE(PG8_SA(0, 0), a2, voffA);
            PG8_BAR; PG8_WAIT_L(0); PG8_MMA(1, 0, At, B0); PG8_BAR; PG8_SCHED;
            PG8_STAGE(PG8_SB(0, 1), b2 + hstep, voffB);
            PG8_WAIT_V(6); PG8_BAR; PG8_MMA(1, 1, At, B1); PG8_BAR;
            PG8_LDB(B0, 1, 0); PG8_SCHED; PG8_LDA(At, 1, 0); PG8_STAGE(PG8_SA(0, 1), a2 + hstep, voffA);
            PG8_WAIT_L(8); PG8_BAR; PG8_WAIT_L(0); PG8_MMA(0, 0, At, B0); PG8_BAR; PG8_SCHED;
            PG8_LDB(B1, 1, 1); PG8_STAGE(PG8_SB(1, 0), b3, voffB);
            PG8_BAR; PG8_WAIT_L(0); PG8_MMA(0, 1, At, B1); PG8_BAR;
            PG8_LDA(At, 1, 1); PG8_STAGE(PG8_SA(1, 0), a3, voffA);
            PG8_BAR; PG8_WAIT_L(0); PG8_MMA(1, 0, At, B0); PG8_BAR; PG8_SCHED;
            PG8_STAGE(PG8_SB(1, 1), b3 + hstep, voffB);
            PG8_WAIT_V(6); PG8_BAR; PG8_MMA(1, 1, At, B1); PG8_BAR;
            }
        }
        if constexpr (ALIGN_EPI) { if (wr == 0) PG8_BAR; }
        if constexpr (!Epi::AFTER_DRAIN) { E(acc, cur, wr, wc, fr, fq); S.done(cur); }
        if (!has_next) break;
#pragma unroll
        for (int a = 0; a < 2; ++a)
#pragma unroll
            for (int b = 0; b < 2; ++b)
#pragma unroll
                for (int m = 0; m < 4; ++m)
#pragma unroll
                    for (int n = 0; n < 2; ++n) acc[a][b][m][n] = (f32x4){0.f, 0.f, 0.f, 0.f};
        cur = nxt; cA = nA; cB = nB; ++ui;
        if constexpr (ALIGN_EPI) { if (wr == 1) PG8_BAR; }
    }
    PG8_WAIT_V(0);
    if constexpr (!ALIGN_EPI) { if (wr == 0) PG8_BAR; }
    PG8_BAR;
    if constexpr (Epi::AFTER_DRAIN) { E.fused(acc, cur, wr, wc, fr, fq, lds, wid, lane); S.done(cur); }
#undef PG8_SA
#undef PG8_SB
#undef PG8_STAGE
#undef PG8_LDA
#undef PG8_LDB
#undef PG8_MMA
#undef PG8_WAIT_V
#undef PG8_WAIT_L
#undef PG8_BAR
#undef PG8_SCHED
}
}
#define GAS __attribute__((address_space(1)))
#define LAS __attribute__((address_space(3)))
typedef unsigned short bf16;
typedef unsigned v4u __attribute__((ext_vector_type(4)));
typedef unsigned v2u __attribute__((ext_vector_type(2)));
typedef float f32x4 __attribute__((ext_vector_type(4)));
typedef float f32x16 __attribute__((ext_vector_type(16)));
typedef short bf16x8 __attribute__((ext_vector_type(8)));
typedef short s16x4 __attribute__((ext_vector_type(4)));
typedef GAS unsigned gu32;
#define RLX_AGENT __ATOMIC_RELAXED, __HIP_MEMORY_SCOPE_AGENT
#define LDS_WAIT() asm volatile("s_waitcnt lgkmcnt(0)" ::: "memory")
#define VM_WAIT() asm volatile("s_waitcnt vmcnt(0)" ::: "memory")
#define SBAR() __builtin_amdgcn_sched_barrier(0)
__device__ __forceinline__ unsigned f2bf(float f) { unsigned u = __builtin_bit_cast(unsigned, f); return (u + 0x7fffu + ((u >> 16) & 1u)) >> 16; }
typedef float f32x2_t __attribute__((ext_vector_type(2)));
typedef __bf16 bf16x2_t __attribute__((ext_vector_type(2)));
__device__ __forceinline__ unsigned pk2(float lo, float hi) { f32x2_t v = {lo, hi}; bf16x2_t b = __builtin_convertvector(v, bf16x2_t); return __builtin_bit_cast(unsigned, b); }
__device__ __forceinline__ float bf_lo(unsigned w) { return __builtin_bit_cast(float, w << 16); }
__device__ __forceinline__ float bf_hi(unsigned w) { return __builtin_bit_cast(float, w & 0xffff0000u); }
__device__ __forceinline__ unsigned cvtpk(float lo, float hi) { unsigned r; asm volatile("v_cvt_pk_bf16_f32 %0, %1, %2" : "=v"(r) : "v"(lo), "v"(hi)); return r; }
template <int CTRL> __device__ __forceinline__ float dppx(float x) { return __builtin_bit_cast(float, __builtin_amdgcn_update_dpp(0, __builtin_bit_cast(int, x), CTRL, 0xf, 0xf, true)); }
__device__ __forceinline__ float wave_sum(float v) {
    v += dppx<0xB1>(v);
    v += dppx<0x4E>(v);
    v += dppx<0x141>(v);
    v += dppx<0x140>(v);
    { auto r = __builtin_amdgcn_permlane16_swap(__float_as_uint(v), __float_as_uint(v), false, false); v = __uint_as_float(r[0]) + __uint_as_float(r[1]); }
    { auto r = __builtin_amdgcn_permlane32_swap(__float_as_uint(v), __float_as_uint(v), false, false); v = __uint_as_float(r[0]) + __uint_as_float(r[1]); }
    return v;
}
__device__ __forceinline__ float silu_f(float x) { return x * __builtin_amdgcn_rcpf(1.f + __builtin_amdgcn_exp2f(-1.4426950408889634f * x)); }
__device__ __forceinline__ void sincos_cw(float a, float& s, float& c) {
    const float k = rintf(a * 0.15915494309189535f);
    float r = fmaf(-k, 6.2831854820251465f, a);
    r = fmaf(-k, -1.7484555314695172e-07f, r);
    s = __sinf(r); c = __cosf(r);
}
__device__ __forceinline__ int opaque_tid(int wave) { return pg8::tid_of(wave); }
__device__ __forceinline__ unsigned cvtpk_s(float lo, float hi) { f32x2_t v = {lo, hi}; bf16x2_t b = __builtin_convertvector(v, bf16x2_t); return __builtin_bit_cast(unsigned, b); }
#define XB_TMO      128
#define XB_XCNT(j)  (256  + 64 * (j))
#define XB_XSUB(j)  (1280 + 64 * (j))
#define XB_XGEN(j)  (2304 + 64 * (j))
#define XB_TOP      3328
#define XB_TOPGEN   3392
#define XCD_BAR_WORDS 3456
#define XB_SPIN_CAP (1u << 18)

__device__ __forceinline__ unsigned xb_ld(unsigned* p)              { return __hip_atomic_load(p, __ATOMIC_RELAXED, __HIP_MEMORY_SCOPE_AGENT); }
__device__ __forceinline__ unsigned xb_add(unsigned* p, unsigned v) { return __hip_atomic_fetch_add(p, v, __ATOMIC_RELAXED, __HIP_MEMORY_SCOPE_AGENT); }
__device__ __forceinline__ unsigned xb_xcc_id() { return (unsigned)__builtin_amdgcn_s_getreg((3 << 11) | 20) & 0xFu; }
#define XB_SPIN(cond, bar) do { unsigned _sp = 0; while (cond) { __builtin_amdgcn_s_sleep(1); \
    if ((++_sp & 255u) == 0u) { if (xb_ld(&(bar)[XB_TMO])) break; if (_sp > XB_SPIN_CAP) { atomicAdd(&(bar)[XB_TMO], 1u); break; } } } } while (0)

struct XcdBarrier {
    unsigned* bar; unsigned x; int wv;
    volatile LAS unsigned* st;
};

__device__ __forceinline__ XcdBarrier xcd_barrier_post(unsigned* bar, volatile LAS unsigned* st) {
    XcdBarrier b; b.bar = bar; b.x = xb_xcc_id(); b.st = st; b.wv = __builtin_amdgcn_readfirstlane(threadIdx.x >> 6);
    if (threadIdx.x == 0) (void)xb_add(&bar[XB_XCNT(b.x)], 1u);
    return b;
}
__device__ __forceinline__ void xcd_barrier_complete(unsigned* bar, unsigned x, unsigned& nloc, unsigned& nx) {
    const unsigned G = gridDim.x * gridDim.y * gridDim.z;
    unsigned sum, cnt, mine, sp = 0u;
    for (;;) {
        sum = 0u; cnt = 0u; mine = 0u;
#pragma unroll
        for (unsigned j = 0; j < 16; ++j) { const unsigned c = xb_ld(&bar[XB_XCNT(j)]); sum += c; cnt += (c > 0u) ? 1u : 0u; mine = (j == x) ? c : mine; }
        if (sum == G) break;
        __builtin_amdgcn_s_sleep(1);
        if ((++sp & 255u) == 0u) { if (xb_ld(&bar[XB_TMO])) break; if (sp > XB_SPIN_CAP) { atomicAdd(&bar[XB_TMO], 1u); break; } }
    }
    nloc = mine > 0u ? mine : 1u; nx = cnt > 0u ? cnt : 1u;
}

__device__ __forceinline__ void xcd_barrier(const XcdBarrier& b) {
    asm volatile("s_waitcnt vmcnt(0)" ::: "memory");
    __syncthreads();
    if (pg8::tid_of(b.wv) == 0) {
        unsigned* bar = b.bar;
        __builtin_amdgcn_s_waitcnt(0);
        unsigned nloc = b.st[0], nx = b.st[1];
        if (nloc == 0u) { xcd_barrier_complete(bar, b.x, nloc, nx); b.st[0] = nloc; b.st[1] = nx; }
        const unsigned old = xb_add(&bar[XB_XSUB(b.x)], 1u);
        const unsigned gen = old / nloc;
        if (old + 1u == (gen + 1u) * nloc) {
            __builtin_amdgcn_fence(__ATOMIC_RELEASE, "agent");
            asm volatile("s_waitcnt vmcnt(0)" ::: "memory");
            const unsigned og = xb_add(&bar[XB_TOP], 1u);
            const unsigned tg = og / nx;
            if (og + 1u == (tg + 1u) * nx) xb_add(&bar[XB_TOPGEN], 1u);
            else XB_SPIN(xb_ld(&bar[XB_TOPGEN]) == tg, bar);
            __builtin_amdgcn_fence(__ATOMIC_ACQUIRE, "agent");
            xb_add(&bar[XB_XGEN(b.x)], 1u);
            asm volatile("s_waitcnt vmcnt(0)" ::: "memory");
        } else {
            XB_SPIN(xb_ld(&bar[XB_XGEN(b.x)]) == gen, bar);
            __builtin_amdgcn_fence(__ATOMIC_ACQUIRE, "agent");
            asm volatile("s_waitcnt vmcnt(0)" ::: "memory");
        }
    }
    __syncthreads();
}
constexpr int NWAVES = 8, NTHR = 512;
constexpr int DM = 2048, NB = 4, SEQ = 4096, CTXL = 256, RPB = SEQ + CTXL  , MROWS = NB * RPB  ;
constexpr int DFF = 5632, DFF2 = 2 * DFF, DEPTH = 4, MODW = 6 * DM  ;
constexpr int GA_N = 3072, RT_N = 16384, DF_N = 6144, RT_V = 4096;
constexpr float EPS = 1e-6f;
constexpr size_t MiB = 1u << 20;
constexpr size_t WS_CTL = 0, CTL_ZERO_BYTES = 1 * MiB;
constexpr size_t WS_MOD = 16 * MiB;
constexpr size_t WS_W_FFN_IN = 17 * MiB;
constexpr size_t WS_W_FFN_OUT = 193 * MiB;
constexpr size_t WS_W_GA_QKV = 281 * MiB;
constexpr size_t WS_W_GA_WO = 305 * MiB;
constexpr size_t WS_W_RT_IN = 321 * MiB;
constexpr size_t WS_W_RT_WO = 385 * MiB;
constexpr size_t WS_W_DF_QKV = 401 * MiB;
constexpr size_t WS_W_DF_WO = 425 * MiB;
constexpr size_t WS_H = 433 * MiB;
constexpr size_t WS_ABUF = 569 * MiB;
constexpr size_t WS_PROJ = 637 * MiB;
constexpr size_t WS_OBUF = 1181 * MiB;
constexpr size_t WS_XBUF = 1368 * MiB, WS_MODP = WS_XBUF;
constexpr size_t WS_ROPE = 1504 * MiB;
constexpr size_t WS_ROPE_RT = 1506 * MiB;
constexpr size_t WS_END = 1510 * MiB;
constexpr int PART_G = 256, PART_GEMM = 168;
constexpr int CW_DQ_NEXT = 64  , CW_DQ_DONE = 640;
constexpr unsigned DQ_STOP_AT = 25;
constexpr int MOD_KS = 32;
constexpr int CW_BAR = 4096;
constexpr int RING_BYTES = 131072, MISC_OFF = RING_BYTES + 320, LDS_BYTES = 147456;
struct Frame {
    LAS unsigned char* lds;
    volatile LAS unsigned* MISC;
    gu32* ctl;
    int tid, lane, wave, G, bid, gw, NGW;
};
struct Args { const float* in[24]; float* out; unsigned char* ws; int ph_lo, ph_hi; };

struct TrDesc { const float* W; bf16* WT; int K, N, item, abpair, qkcols, hd; };
__device__ __forceinline__ void tr_load(f32x4 (&wv)[8], const TrDesc& d, int lane) {
    const int nblk = d.N / 32, kb = d.item / nblk, nb = d.item % nblk, k0 = 64 * kb, n0 = 32 * nb;
    const int r8 = lane >> 3, c4 = (lane & 7) * 4;
#pragma unroll
    for (int i = 0; i < 8; ++i) wv[i] = __builtin_nontemporal_load((const GAS f32x4*)(d.W + (size_t)(k0 + 8 * i + r8) * d.N + n0 + c4));
}
__device__ __forceinline__ void tr_finish(const f32x4 (&wv)[8], const TrDesc& d, LAS float* scr, int lane) {
    const int nblk = d.N / 32, kb = d.item / nblk, nb = d.item % nblk, k0 = 64 * kb, n0 = 32 * nb;
    { const int r8 = lane >> 3, c4 = (lane & 7) * 4;
#pragma unroll
      for (int i = 0; i < 8; ++i) { LAS float* q = scr + (8 * i + r8) * 33 + c4; q[0] = wv[i].x; q[1] = wv[i].y; q[2] = wv[i].z; q[3] = wv[i].w; } }
    LDS_WAIT(); asm volatile("" ::: "memory");
    const int c = lane & 7;
#pragma unroll
    for (int j = 0; j < 4; ++j) { const int n = (lane >> 3) + 8 * j; const LAS float* s = scr + (8 * c) * 33 + n;
        v4u o; o.x = pk2(s[0 * 33], s[1 * 33]); o.y = pk2(s[2 * 33], s[3 * 33]); o.z = pk2(s[4 * 33], s[5 * 33]); o.w = pk2(s[6 * 33], s[7 * 33]);
        int drow = n0 + n; if (drow < d.qkcols) { const int dd = drow & (d.hd - 1), hh = d.hd >> 1; drow = (drow & ~(d.hd - 1)) + (dd < hh ? 2 * dd : 2 * (dd - hh) + 1); }
        if (d.abpair) { const int cc = drow < 5632 ? drow : drow - 5632; drow = (cc >> 7) * 256 + (cc & 127) + (drow < 5632 ? 0 : 128); }
        __builtin_nontemporal_store(o, (GAS v4u*)(d.WT + (size_t)drow * d.K + k0 + 8 * c)); }
    LDS_WAIT(); asm volatile("" ::: "memory");
}
constexpr int WI_FI = (DM / 64) * (DFF2 / 32), WI_FO = (DFF / 64) * (DM / 32), WI_GQ = (DM / 64) * (GA_N / 32), WI_GO = (DM / 64) * (DM / 32),
              WI_RI = (DM / 64) * (RT_N / 32), WI_RO = (RT_V / 64) * (DM / 32), WI_DQ = (DM / 64) * (DF_N / 32), WI_DO = (DM / 64) * (DM / 32);
constexpr int W_EARLY = WI_GQ + WI_GO, W_NITEMS = 4 * WI_FI + 4 * WI_FO + 2 * WI_GQ + 2 * WI_GO + WI_RI + WI_RO + WI_DQ + WI_DO;
__device__ __forceinline__ TrDesc p0_weight_desc(const Args& a, int r) {
    unsigned char* ws = a.ws;
    if (r < WI_GQ) return TrDesc{a.in[11], (bf16*)(ws + WS_W_GA_QKV), DM, GA_N, r, 0, 2560, 128}; r -= WI_GQ;
    if (r < WI_GO) return TrDesc{a.in[14], (bf16*)(ws + WS_W_GA_WO), DM, DM, r, 0, 0, 128}; r -= WI_GO;
    if (r < 4 * WI_FI) { const int l = r / WI_FI; return TrDesc{a.in[7] + (size_t)l * DM * DFF2, (bf16*)(ws + WS_W_FFN_IN) + (size_t)l * DFF2 * DM, DM, DFF2, r % WI_FI, 1, 0, 128}; } r -= 4 * WI_FI;
    if (r < 4 * WI_FO) { const int l = r / WI_FO; return TrDesc{a.in[10] + (size_t)l * DFF * DM, (bf16*)(ws + WS_W_FFN_OUT) + (size_t)l * DM * DFF, DFF, DM, r % WI_FO, 0, 0, 128}; } r -= 4 * WI_FO;
    if (r < WI_RI) return TrDesc{a.in[15], (bf16*)(ws + WS_W_RT_IN), DM, RT_N, r, 0, 4096, 256}; r -= WI_RI;
    if (r < WI_RO) return TrDesc{a.in[18], (bf16*)(ws + WS_W_RT_WO), RT_V, DM, r, 0, 0, 128}; r -= WI_RO;
    if (r < WI_DQ) return TrDesc{a.in[19], (bf16*)(ws + WS_W_DF_QKV), DM, DF_N, r, 0, 4096, 128}; r -= WI_DQ;
    if (r < WI_DO) return TrDesc{a.in[23], (bf16*)(ws + WS_W_DF_WO), DM, DM, r, 0, 0, 128}; r -= WI_DO;
    if (r < WI_GQ) return TrDesc{a.in[11] + (size_t)DM * GA_N, (bf16*)(ws + WS_W_GA_QKV) + (size_t)GA_N * DM, DM, GA_N, r, 0, 2560, 128}; r -= WI_GQ;
    return TrDesc{a.in[14] + (size_t)DM * DM, (bf16*)(ws + WS_W_GA_WO) + (size_t)DM * DM, DM, DM, r, 0, 0, 128};
}
__device__ __forceinline__ void p0_weight_item(const Args& a, LAS float* scr, int r, int lane) { const TrDesc d = p0_weight_desc(a, r); f32x4 wv[8]; tr_load(wv, d, lane); tr_finish(wv, d, scr, lane); }
__device__ __forceinline__ void dq_work(Frame& F0, const Args& a, bool until_gemm) {
    Frame F = F0; F.tid = opaque_tid(F0.wave); F.lane = F.tid & 63;
    if (F.G != PART_G) return;
    LAS float* scr = (LAS float*)(F.lds + F.wave * 16384);
    unsigned* ctl = (unsigned*)F.ctl;
    constexpr unsigned NDEF = (unsigned)(W_NITEMS - W_EARLY), KPS = NDEF / 16u;
    static_assert(NDEF % 16u == 0u, "8 streams of pairs");
    if (!until_gemm) {
#pragma unroll 1
        for (unsigned x = 0; x < 8u; ++x) {
            unsigned r0 = 0u; if (F.lane == 0) r0 = xb_ld(&ctl[CW_DQ_NEXT + 64 * x]); r0 = (unsigned)__builtin_amdgcn_readfirstlane((int)r0);
            for (unsigned k = r0 + (unsigned)F.gw; k < KPS; k += (unsigned)F.NGW) { const int it = W_EARLY + 2 * (int)(x + 8u * k);
                p0_weight_item(a, scr, it, F.lane); p0_weight_item(a, scr, it + 1, F.lane); }
        }
        return;
    }
    unsigned* cnt = &ctl[CW_DQ_NEXT + 64 * (F.bid & 7)]; const int x = F.bid & 7;
    unsigned ka = 0u, kb = 0u; if (F.lane == 0) { ka = xb_add(cnt, 1u); kb = xb_add(cnt, 1u); }
    ka = (unsigned)__builtin_amdgcn_readfirstlane((int)ka); kb = (unsigned)__builtin_amdgcn_readfirstlane((int)kb);
    unsigned seen = 0u;
    f32x4 wvA[8], wvB[8]; TrDesc dA, dB;
#define DQ_ITEM(k_) (W_EARLY + 2 * (x + 8 * (int)(k_)))
    if (ka < KPS) { dA = p0_weight_desc(a, DQ_ITEM(ka)); dB = p0_weight_desc(a, DQ_ITEM(ka) + 1); tr_load(wvA, dA, F.lane); tr_load(wvB, dB, F.lane); }
    while (ka < KPS) {
        const bool stop = seen >= DQ_STOP_AT;
        unsigned kn = KPS, dn = 0u;
        if (!stop && kb < KPS && F.lane == 0) { kn = xb_add(cnt, 1u); dn = xb_ld(&ctl[CW_DQ_DONE]); }
        tr_finish(wvA, dA, scr, F.lane);
        if (kb < KPS) { dA = p0_weight_desc(a, DQ_ITEM(kb)); tr_load(wvA, dA, F.lane); }
        tr_finish(wvB, dB, scr, F.lane);
        if (kb < KPS) { dB = p0_weight_desc(a, DQ_ITEM(kb) + 1); tr_load(wvB, dB, F.lane); }
        ka = kb; kb = (unsigned)__builtin_amdgcn_readfirstlane((int)kn); seen = (unsigned)__builtin_amdgcn_readfirstlane((int)dn);
    }
#undef DQ_ITEM
}
__device__ __forceinline__ void p0_prologue(Frame& F0, const Args& a) {
    Frame F = F0; F.tid = opaque_tid(F0.wave); F.lane = F.tid & 63;
    unsigned char* ws = a.ws;
    {
        LAS float* tab = (LAS float*)F.lds;
        for (int i = F.tid; i < 2048 * 5; i += NTHR) { const int v = i / 2048, k = i % 2048; const float x = (v < 4) ? a.in[1][v * 2048 + k] : a.in[3][k]; tab[k * 8 + v] = silu_f(x); }
        __syncthreads();
        float* modp = (float*)(ws + WS_MODP);
        for (int it = F.gw; it < DEPTH * 48 * MOD_KS; it += F.NGW) {
            const int l = it / (48 * MOD_KS), r = it % (48 * MOD_KS), nb = r / MOD_KS, ks = r % MOD_KS;
            const float* W = a.in[4] + ((size_t)l * 2048 + ks * (2048 / MOD_KS)) * MODW + nb * 256 + 4 * F.lane;
            f32x4 acc[5];
#pragma unroll
            for (int v = 0; v < 5; ++v) acc[v] = (f32x4){0.f, 0.f, 0.f, 0.f};
#pragma unroll 8
            for (int kk = 0; kk < 2048 / MOD_KS; ++kk) {
                const f32x4 w = *(const GAS f32x4*)(W + (size_t)kk * MODW);
                const LAS float* t = tab + (ks * (2048 / MOD_KS) + kk) * 8;
                const f32x4 s4 = *(const LAS f32x4*)t; const float s5 = t[4];
                acc[0] += w * s4[0]; acc[1] += w * s4[1]; acc[2] += w * s4[2]; acc[3] += w * s4[3]; acc[4] += w * s5;
            }
#pragma unroll
            for (int v = 0; v < 5; ++v) *(GAS f32x4*)(modp + ((size_t)(l * MOD_KS + ks) * 5 + v) * MODW + nb * 256 + 4 * F.lane) = acc[v];
        }
        __syncthreads();
    }
    {
        LAS float* scr = (LAS float*)(F.lds + F.wave * 16384);
        const int nit = (F.G == PART_G) ? W_EARLY : W_NITEMS;
        for (int it = F.gw; it < nit; it += F.NGW) p0_weight_item(a, scr, it, F.lane);
    }
    {
        float* tab = (float*)(ws + WS_ROPE);
        for (int i = F.bid * NTHR + F.tid; i < SEQ * 64; i += F.G * NTHR) {
            const int t = i >> 6, p = i & 63;
            const float inv = exp2f(-(float)(p & 31) * 0.4152410118609203f);
            const float pos = (float)((p < 32) ? (t >> 6) : (t & 63));
            float sn, cs; sincos_cw(pos * inv, sn, cs);
            tab[(size_t)t * 128 + p] = cs; tab[(size_t)t * 128 + 64 + p] = sn;
        }
        float* tab2 = (float*)(ws + WS_ROPE_RT);
        for (int i = F.bid * NTHR + F.tid; i < SEQ * 128; i += F.G * NTHR) {
            const int t = i >> 7, p = i & 127;
            const float inv = exp2f(-(float)p * 0.10381025296523008f);
            float sn, cs; sincos_cw((float)t * inv, sn, cs);
            tab2[(size_t)t * 256 + p] = cs; tab2[(size_t)t * 256 + 128 + p] = sn;
        }
    }
}
__device__ __forceinline__ void p0b_modfinal(Frame& F0, const Args& a) {
    Frame F = F0; F.tid = opaque_tid(F0.wave); F.lane = F.tid & 63;
    const float* modp = (const float*)(a.ws + WS_MODP); float* mod = (float*)(a.ws + WS_MOD);
    for (int i = F.bid * NTHR + F.tid; i < DEPTH * 5 * MODW; i += F.G * NTHR) {
        const int n = i % MODW, v = (i / MODW) % 5, l = i / (5 * MODW);
        float s = a.in[5][l * MODW + n];
#pragma unroll
        for (int ks = 0; ks < MOD_KS; ++ks) s += modp[((size_t)(l * MOD_KS + ks) * 5 + v) * MODW + n];
        mod[i] = s;
    }
}
__device__ __forceinline__ int norm_col(int lane, int q) { return 8 * lane + 512 * (q >> 1) + 4 * (q & 1); }
__device__ __forceinline__ void norm_load_row(f32x4 (&x)[8], const float* fsrc, const bf16* hsrc, int lane) {
    if (fsrc != nullptr) {
#pragma unroll
        for (int q = 0; q < 8; ++q) x[q] = *(const GAS f32x4*)(fsrc + norm_col(lane, q));
    } else {
        v4u w[4];
#pragma unroll
        for (int Q = 0; Q < 4; ++Q) w[Q] = *(const GAS v4u*)(hsrc + 8 * lane + 512 * Q);
#pragma unroll
        for (int Q = 0; Q < 4; ++Q) { x[2 * Q] = (f32x4){pg8::h_lo(w[Q].x), pg8::h_hi(w[Q].x), pg8::h_lo(w[Q].y), pg8::h_hi(w[Q].y)};
            x[2 * Q + 1] = (f32x4){pg8::h_lo(w[Q].z), pg8::h_hi(w[Q].z), pg8::h_lo(w[Q].w), pg8::h_hi(w[Q].w)}; }
    }
}
__device__ __forceinline__ float norm_rstd(const f32x4 (&x)[8]) {
    float ss = 0.f;
#pragma unroll
    for (int q = 0; q < 8; ++q) ss += (x[q].x * x[q].x + x[q].y * x[q].y) + (x[q].z * x[q].z + x[q].w * x[q].w);
    return __builtin_amdgcn_rsqf(wave_sum(ss) * (1.f / DM) + EPS);
}
__device__ __forceinline__ f32x4 norm_y(const f32x4 x, float rstd, const float* g, const float* sh, const float* sc, int col) {
    const f32x4 gv = *(const GAS f32x4*)(g + col), shv = *(const GAS f32x4*)(sh + col), scv = *(const GAS f32x4*)(sc + col);
    return (x * rstd * gv) * (scv + 1.f) + shv;
}
__device__ __forceinline__ void norm_mod_phase(Frame& F0, const Args& a, int layer, int which, int lat_only, const float* pgate, const float* xsrc, const float* csrc) {
    Frame F = F0; F.tid = opaque_tid(F0.wave); F.lane = F.tid & 63;
    bf16* h = (bf16*)(a.ws + WS_H); bf16* ab = (bf16*)(a.ws + WS_ABUF); const bf16* part = (const bf16*)(a.ws + WS_XBUF);
    const float* g = a.in[6] + (size_t)(layer * 2 + which) * DM;
    const float* modl = (const float*)(a.ws + WS_MOD) + (size_t)layer * 5 * MODW;
    const int wv = __builtin_amdgcn_readfirstlane(F.tid >> 6);
    if (!lat_only && wv < 4) {
        const float* sh = modl + (size_t)4 * MODW + (which * 3 + 0) * DM; const float* sc = modl + (size_t)4 * MODW + (which * 3 + 1) * DM;
        for (int crow = F.bid * 4 + wv; crow < NB * CTXL; crow += F.G * 4) {
            const size_t row = (size_t)(crow / CTXL) * RPB + (crow % CTXL);
            f32x4 x[8];
            norm_load_row(x, csrc ? csrc + (size_t)crow * DM : (const float*)nullptr, h + row * DM, F.lane);
            if (pgate != nullptr) {
#pragma unroll
                for (int Q = 0; Q < 4; ++Q) { const int col = 8 * F.lane + 512 * Q; f32x4 s0 = (f32x4){0.f, 0.f, 0.f, 0.f}, s1 = s0;
                    v4u pw[8];
#pragma unroll
                    for (int ks = 0; ks < 8; ++ks) pw[ks] = *(const GAS v4u*)(part + ((size_t)ks * 1024 + crow) * DM + col);
#pragma unroll
                    for (int ks = 0; ks < 8; ++ks) { s0 += (f32x4){pg8::h_lo(pw[ks].x), pg8::h_hi(pw[ks].x), pg8::h_lo(pw[ks].y), pg8::h_hi(pw[ks].y)};
                        s1 += (f32x4){pg8::h_lo(pw[ks].z), pg8::h_hi(pw[ks].z), pg8::h_lo(pw[ks].w), pg8::h_hi(pw[ks].w)}; }
                    x[2 * Q] += *(const GAS f32x4*)(pgate + col) * s0; x[2 * Q + 1] += *(const GAS f32x4*)(pgate + col + 4) * s1;
                    v4u hw; hw.x = pg8::pk2h(x[2 * Q].x, x[2 * Q].y); hw.y = pg8::pk2h(x[2 * Q].z, x[2 * Q].w); hw.z = pg8::pk2h(x[2 * Q + 1].x, x[2 * Q + 1].y); hw.w = pg8::pk2h(x[2 * Q + 1].z, x[2 * Q + 1].w);
                    *(GAS v4u*)(h + row * DM + col) = hw; }
            }
            const float rstd = norm_rstd(x);
#pragma unroll
            for (int Q = 0; Q < 4; ++Q) { const int col = 8 * F.lane + 512 * Q;
                const f32x4 ya = norm_y(x[2 * Q], rstd, g, sh, sc, col), yb = norm_y(x[2 * Q + 1], rstd, g, sh, sc, col + 4);
                v4u w; w.x = pk2(ya.x, ya.y); w.y = pk2(ya.z, ya.w); w.z = pk2(yb.x, yb.y); w.w = pk2(yb.z, yb.w); *(GAS v4u*)(ab + row * DM + col) = w; }
        }
    }
    const int nh = (!lat_only && pgate != nullptr) ? 3 : 4, nl = 8 - nh;
    const int ns = wv < 4 ? nh : nl, s0 = wv < 4 ? nh * wv : 4 * nh + nl * (wv - 4);
    constexpr int NPAIR = NB * SEQ / 2;
    for (int base = F.bid * 32 + s0; base < NPAIR; base += F.G * 32)
        for (int s = 0; s < ns; ++s) {
            const int p = base + s; if (p >= NPAIR) break;
            const int r0 = 2 * p, b = r0 / SEQ, t = r0 % SEQ; const size_t row = (size_t)b * RPB + CTXL + t;
            const float* sh = modl + (size_t)b * MODW + (which * 3 + 0) * DM; const float* sc = modl + (size_t)b * MODW + (which * 3 + 1) * DM;
            f32x4 x0[8], x1[8];
            norm_load_row(x0, xsrc ? xsrc + (size_t)r0 * DM : (const float*)nullptr, h + row * DM, F.lane);
            norm_load_row(x1, xsrc ? xsrc + (size_t)(r0 + 1) * DM : (const float*)nullptr, h + (row + 1) * DM, F.lane);
            const float rs0 = norm_rstd(x0), rs1 = norm_rstd(x1);
#pragma unroll
            for (int Q = 0; Q < 4; ++Q) { const int col = 8 * F.lane + 512 * Q;
                const f32x4 ga = *(const GAS f32x4*)(g + col), sha = *(const GAS f32x4*)(sh + col), sca = *(const GAS f32x4*)(sc + col) + 1.f;
                const f32x4 gb = *(const GAS f32x4*)(g + col + 4), shb = *(const GAS f32x4*)(sh + col + 4), scb = *(const GAS f32x4*)(sc + col + 4) + 1.f;
                const f32x4 y0a = (x0[2 * Q] * rs0 * ga) * sca + sha, y0b = (x0[2 * Q + 1] * rs0 * gb) * scb + shb;
                const f32x4 y1a = (x1[2 * Q] * rs1 * ga) * sca + sha, y1b = (x1[2 * Q + 1] * rs1 * gb) * scb + shb;
                v4u w0, w1; w0.x = pk2(y0a.x, y0a.y); w0.y = pk2(y0a.z, y0a.w); w0.z = pk2(y0b.x, y0b.y); w0.w = pk2(y0b.z, y0b.w);
                w1.x = pk2(y1a.x, y1a.y); w1.y = pk2(y1a.z, y1a.w); w1.z = pk2(y1b.x, y1b.y); w1.w = pk2(y1b.z, y1b.w);
                *(GAS v4u*)(ab + row * DM + col) = w0; *(GAS v4u*)(ab + (row + 1) * DM + col) = w1; }
        }
}
__device__ __forceinline__ void unpack8(const v4u w, float* x) { x[0] = bf_lo(w.x); x[1] = bf_hi(w.x); x[2] = bf_lo(w.y); x[3] = bf_hi(w.y); x[4] = bf_lo(w.z); x[5] = bf_hi(w.z); x[6] = bf_lo(w.w); x[7] = bf_hi(w.w); }
__device__ __forceinline__ void conv_fix_phase(Frame& F0, const Args& a, int layer, int lat_only) {
    Frame F = F0; F.tid = opaque_tid(F0.wave); F.lane = F.tid & 63;
    const bf16* ed = (const bf16*)(a.ws + WS_PROJ); bf16* go = (bf16*)(a.ws + WS_OBUF);
    const float* cw = a.in[8] + (size_t)layer * 3 * DFF2; const float* cb = a.in[9] + (size_t)layer * DFF2;
    constexpr int NRUN = MROWS / 64;
    for (int it = F.gw; it < (NRUN - 1) * 11; it += F.NGW) {
        const int cbk = it % 11, k = it / 11;
        const int r2 = 64 * (k + 1), j2 = r2 % RPB;
        if (j2 == 0 || j2 == CTXL) continue;
        if (lat_only && j2 < CTXL) continue;
        const int c0 = cbk * 512 + F.lane * 8;
        float wa[3][8], wb[3][8], ba[8], bb[8];
#pragma unroll
        for (int t = 0; t < 3; ++t)
#pragma unroll
            for (int e = 0; e < 8; ++e) { wa[t][e] = cw[t * DFF2 + c0 + e]; wb[t][e] = cw[t * DFF2 + DFF + c0 + e]; }
#pragma unroll
        for (int e = 0; e < 8; ++e) { ba[e] = cb[c0 + e]; bb[e] = cb[DFF + c0 + e]; }
        float xa[4][8], xb[4][8];
#pragma unroll
        for (int q = 0; q < 4; ++q) { const bf16* p = ed + ((size_t)(q < 2 ? k : k + 1) * 4 + (q < 2 ? 2 + q : q - 2)) * DFF2 + c0;
            unpack8(*(const GAS v4u*)p, xa[q]); unpack8(*(const GAS v4u*)(p + DFF), xb[q]); }
#pragma unroll
        for (int q = 0; q < 2; ++q) {
            float y[8];
#pragma unroll
            for (int e = 0; e < 8; ++e) {
                const float va = ba[e] + wa[0][e] * xa[q][e] + wa[1][e] * xa[q + 1][e] + wa[2][e] * xa[q + 2][e];
                const float vb = bb[e] + wb[0][e] * xb[q][e] + wb[1][e] * xb[q + 1][e] + wb[2][e] * xb[q + 2][e];
                y[e] = va * __builtin_amdgcn_rcpf(1.f + __builtin_amdgcn_exp2f(-1.4426950408889634f * va)) * vb; }
            v4u ow; ow.x = pk2(y[0], y[1]); ow.y = pk2(y[2], y[3]); ow.z = pk2(y[4], y[5]); ow.w = pk2(y[6], y[7]);
            *(GAS v4u*)(go + (size_t)(r2 - 1 + q) * DFF + c0) = ow;
        }
    }
}
__device__ __forceinline__ void df_combine_phase(Frame& F0, const Args& a, float linit) {
    Frame F = F0; F.tid = opaque_tid(F0.wave); F.lane = F.tid & 63;
    const bf16* O = (const bf16*)(a.ws + WS_OBUF); bf16* ab = (bf16*)(a.ws + WS_ABUF);
    const float* lam = a.in[20]; const float* sg = a.in[22];
    float l0 = lam[F.lane] * lam[128 + F.lane] + lam[64 + F.lane] * lam[192 + F.lane];
    float l1 = lam[256 + F.lane] * lam[384 + F.lane] + lam[320 + F.lane] * lam[448 + F.lane];
    l0 = wave_sum(l0); l1 = wave_sum(l1);
    const float lmb = expf(l0) - expf(l1) + linit;
    const f32x4 sgv = *(const GAS f32x4*)(sg + 4 * F.lane);
    for (int row = F.gw; row < MROWS; row += F.NGW) {
        v2u w0[8], w1[8];
#pragma unroll
        for (int hh = 0; hh < 8; ++hh) { w0[hh] = *(const GAS v2u*)(O + (size_t)row * 4096 + hh * 256 + 4 * F.lane); w1[hh] = *(const GAS v2u*)(O + (size_t)row * 4096 + 2048 + hh * 256 + 4 * F.lane); }
#pragma unroll
        for (int hh = 0; hh < 8; ++hh) {
            const float o0 = bf_lo(w0[hh].x) - lmb * bf_lo(w1[hh].x), o1 = bf_hi(w0[hh].x) - lmb * bf_hi(w1[hh].x), o2 = bf_lo(w0[hh].y) - lmb * bf_lo(w1[hh].y), o3 = bf_hi(w0[hh].y) - lmb * bf_hi(w1[hh].y);
            const float ss = wave_sum((o0 * o0 + o1 * o1) + (o2 * o2 + o3 * o3));
            const float r = __builtin_amdgcn_rsqf(ss * (1.f / 256.f) + EPS) * (1.f - linit);
            v2u ow; ow.x = pk2(o0 * r * sgv.x, o1 * r * sgv.y); ow.y = pk2(o2 * r * sgv.z, o3 * r * sgv.w);
            *(GAS v2u*)(ab + (size_t)row * DM + hh * 256 + 4 * F.lane) = ow;
        }
    }
}
__device__ __forceinline__ void rt_combine_phase(Frame& F0, const Args& a) {
    Frame F = F0; F.tid = opaque_tid(F0.wave); F.lane = F.tid & 63;
    bf16* of = (bf16*)(a.ws + WS_OBUF); const bf16* ob = (const bf16*)(a.ws + WS_XBUF); const bf16* proj = (const bf16*)(a.ws + WS_PROJ);
    const float* gn = a.in[17];
    for (int it0 = F.gw; it0 < MROWS * 8; it0 += 2 * F.NGW) {
        v4u wf[2], wb[2], wgf[2], wgb[2]; int rowv[2], colv[2]; bool ok[2];
#pragma unroll
        for (int u = 0; u < 2; ++u) { const int it = it0 + u * F.NGW; ok[u] = it < MROWS * 8; const int itc = ok[u] ? it : it0; rowv[u] = itc >> 3; colv[u] = (itc & 7) * 512 + F.lane * 8;
            wf[u] = *(const GAS v4u*)(of + (size_t)rowv[u] * RT_V + colv[u]); wb[u] = *(const GAS v4u*)(ob + (size_t)rowv[u] * RT_V + colv[u]);
            wgf[u] = *(const GAS v4u*)(proj + (size_t)rowv[u] * RT_N + 8192 + colv[u]); wgb[u] = *(const GAS v4u*)(proj + (size_t)rowv[u] * RT_N + 12288 + colv[u]); }
#pragma unroll
        for (int u = 0; u < 2; ++u) {
            const int row = rowv[u], col = colv[u];
            float xf[8], xb[8], gf[8], gb[8], y[8];
            unpack8(wf[u], xf); unpack8(wb[u], xb); unpack8(wgf[u], gf); unpack8(wgb[u], gb);
            float sf = 0.f, sb = 0.f;
#pragma unroll
            for (int e = 0; e < 8; ++e) { sf += xf[e]; sb += xb[e]; }
            const float muf = wave_sum(sf) * (1.f / 512.f), mub = wave_sum(sb) * (1.f / 512.f);
            float qf = 0.f, qb = 0.f;
#pragma unroll
            for (int e = 0; e < 8; ++e) { xf[e] -= muf; xb[e] -= mub; qf += xf[e] * xf[e]; qb += xb[e] * xb[e]; }
            const float rf = __builtin_amdgcn_rsqf(wave_sum(qf) * (1.f / 512.f) + EPS), rb = __builtin_amdgcn_rsqf(wave_sum(qb) * (1.f / 512.f) + EPS);
#pragma unroll
            for (int e = 0; e < 8; ++e) y[e] = silu_f(gf[e]) * (xf[e] * rf * gn[col + e]) + silu_f(gb[e]) * (xb[e] * rb * gn[RT_V + col + e]);
            v4u ow; ow.x = pk2(y[0], y[1]); ow.y = pk2(y[2], y[3]); ow.z = pk2(y[4], y[5]); ow.w = pk2(y[6], y[7]);
            if (ok[u]) *(GAS v4u*)(of + (size_t)row * RT_V + col) = ow;
        }
    }
}
namespace att {
constexpr int D = 128, QBLK = 32, KVBLK = 64;
constexpr float THR = 8.f;
constexpr size_t SHM_V = KVBLK * D * 2, SHM_K = KVBLK * D * 2, SHM_ATTN = 2 * SHM_V + 2 * SHM_K + NWAVES * 64 * 4;
#define KSWZ(row, colB) ((row) * 256 + ((colB) ^ (((row) & 7) << 4)))
__device__ __forceinline__ int crow(int r, int hi) { return (r & 3) + 8 * (r >> 2) + 4 * hi; }
__device__ __forceinline__ void partialSM(f32x16& p0, f32x16& p1, float& m_reg, float& mn, float& alpha, bool band, int kq0, int qidx, int hi) {
  constexpr float C = 1.4426950408889634f;
  if (band) {
    const int dd = kq0 - qidx + 4 * hi + 128;
#pragma unroll
    for (int r = 0; r < 16; ++r) { const int cr = (r & 3) + 8 * (r >> 2);
      p0[r] = ((unsigned)(dd + cr) > 256u) ? -1e30f : p0[r]; p1[r] = ((unsigned)(dd + cr + 32) > 256u) ? -1e30f : p1[r]; }
  }
  float pmax = p0[0];
#pragma unroll
  for (int r = 1; r < 16; ++r) pmax = fmaxf(pmax, p0[r]);
#pragma unroll
  for (int r = 0; r < 16; ++r) pmax = fmaxf(pmax, p1[r]);
  { auto rr = __builtin_amdgcn_permlane32_swap(__float_as_uint(pmax), __float_as_uint(pmax), false, false);
    pmax = fmaxf(__uint_as_float(rr[0]), __uint_as_float(rr[1])); }
  if (__builtin_expect(__all(pmax - m_reg <= THR), 1)) { mn = m_reg; alpha = 1.f; }
  else { mn = fmaxf(m_reg, pmax); alpha = __builtin_amdgcn_exp2f((m_reg - mn) * C); m_reg = mn; }
  const float mnC = -mn * C;
#pragma unroll
  for (int r = 0; r < 16; ++r) p0[r] = fmaf(p0[r], C, mnC);
#pragma unroll
  for (int r = 0; r < 16; ++r) p1[r] = fmaf(p1[r], C, mnC);
#pragma unroll
  for (int r = 0; r < 16; ++r) p0[r] = __builtin_amdgcn_exp2f(p0[r]);
}
__device__ __forceinline__ void finishSM(f32x16& p0, f32x16& p1, float alpha, float& l_reg, bf16x8& pa0, bf16x8& pa1, bf16x8& pa2, bf16x8& pa3) {
#pragma unroll
  for (int r = 0; r < 16; ++r) p1[r] = __builtin_amdgcn_exp2f(p1[r]);
  float ps = 0;
#pragma unroll
  for (int r = 0; r < 16; ++r) ps += p0[r];
#pragma unroll
  for (int r = 0; r < 16; ++r) ps += p1[r];
  { auto rr = __builtin_amdgcn_permlane32_swap(__float_as_uint(ps), __float_as_uint(ps), false, false);
    ps = __uint_as_float(rr[0]) + __uint_as_float(rr[1]); }
  l_reg = l_reg * alpha + ps;
#define PK4(P, BASE, OUT) do { unsigned a0 = cvtpk(P[BASE + 0], P[BASE + 1]), a1 = cvtpk(P[BASE + 2], P[BASE + 3]);   \
    unsigned b0 = cvtpk(P[BASE + 4], P[BASE + 5]), b1 = cvtpk(P[BASE + 6], P[BASE + 7]);                              \
    auto r0 = __builtin_amdgcn_permlane32_swap(a0, b0, false, false); auto r1 = __builtin_amdgcn_permlane32_swap(a1, b1, false, false); \
    v4u w = {r0[0], r1[0], r0[1], r1[1]}; OUT = *reinterpret_cast<bf16x8*>(&w); } while (0)
  PK4(p0, 0, pa0); PK4(p0, 8, pa1); PK4(p1, 0, pa2); PK4(p1, 8, pa3);
#undef PK4
}
__device__ __forceinline__ void qkt(f32x16& p0, f32x16& p1, const char* Ks, const bf16x8* qr, int r32, int hi) {
  p0 = f32x16{}; p1 = f32x16{};
#pragma unroll
  for (int d0 = 0; d0 < 8; ++d0) { const int cb = (d0 * 16 + hi * 8) * 2;
    bf16x8 b0 = *reinterpret_cast<const bf16x8*>(Ks + KSWZ(r32, cb));
    bf16x8 b1 = *reinterpret_cast<const bf16x8*>(Ks + KSWZ(32 + r32, cb));
    p0 = __builtin_amdgcn_mfma_f32_32x32x16_bf16(b0, qr[d0], p0, 0, 0, 0);
    p1 = __builtin_amdgcn_mfma_f32_32x32x16_bf16(b1, qr[d0], p1, 0, 0, 0); }
}
__device__ __forceinline__ int v_st(int k, int c) { const int kk = (k & ~0xC) | ((k & 4) << 1) | ((k & 8) >> 1); return ((kk >> 3) * 4 + (c >> 5)) * 512 + ((kk & 7) * 32 + (c & 31)) * 2; }
__device__ __forceinline__ int v_rd_base(int lane) { return ((lane & 3) << 3) | (((lane >> 2) & 3) << 6) | (((lane >> 4) & 1) << 5) | (((lane >> 5) & 1) << 8); }
constexpr int v_rd_off(int d0, int ks, int half) { return d0 * 512 + ks * 4096 + half * 2048; }
template <int OFF> __device__ __forceinline__ s16x4 tr_read(int vb) {
  s16x4 r; asm volatile("ds_read_b64_tr_b16 %0, %1 offset:%2" : "=&v"(r) : "v"(vb), "i"(OFF) : "memory"); return r;
}
template <int D0> __device__ __forceinline__ void pv_one(f32x16& od, int vb, bf16x8 pa0, bf16x8 pa1, bf16x8 pa2, bf16x8 pa3) {
  const s16x4 l0 = tr_read<v_rd_off(D0, 0, 0)>(vb), h0 = tr_read<v_rd_off(D0, 0, 1)>(vb), l1 = tr_read<v_rd_off(D0, 1, 0)>(vb), h1 = tr_read<v_rd_off(D0, 1, 1)>(vb);
  const s16x4 l2 = tr_read<v_rd_off(D0, 2, 0)>(vb), h2 = tr_read<v_rd_off(D0, 2, 1)>(vb), l3 = tr_read<v_rd_off(D0, 3, 0)>(vb), h3 = tr_read<v_rd_off(D0, 3, 1)>(vb);
  asm volatile("s_waitcnt lgkmcnt(0)" ::: "memory"); SBAR();
#define PK(L, H) (bf16x8){L[0], L[1], L[2], L[3], H[0], H[1], H[2], H[3]}
  od = __builtin_amdgcn_mfma_f32_32x32x16_bf16(pa0, PK(l0, h0), od, 0, 0, 0);
  od = __builtin_amdgcn_mfma_f32_32x32x16_bf16(pa1, PK(l1, h1), od, 0, 0, 0);
  od = __builtin_amdgcn_mfma_f32_32x32x16_bf16(pa2, PK(l2, h2), od, 0, 0, 0);
  od = __builtin_amdgcn_mfma_f32_32x32x16_bf16(pa3, PK(l3, h3), od, 0, 0, 0);
#undef PK
}
constexpr size_t SHM2_K = 16384, SHM2_V = 32768, SHM_ATTN2 = 2 * SHM2_K + 2 * SHM2_V + NWAVES * 64 * 4;
template <int LDQ, int LDK, int LDO>
__device__ __forceinline__ void attn2_body(const bf16* __restrict__ Qb, const bf16* __restrict__ Kh, const bf16* __restrict__ Vh, bf16* __restrict__ Ob, int NT, char* lds, int wave) {
  const int tid = pg8::tid_of(wave); const int wid = __builtin_amdgcn_readfirstlane(tid >> 6), lane = tid & 63, r32 = lane & 31, hi = lane >> 5;
  char* K_lds = lds; char* V_lds = lds + 2 * SHM2_K;
  float* ws = (float*)(lds + 2 * SHM2_K + 2 * SHM2_V) + wid * 64; float* li_l = ws; float* al_l = ws + 32;
  LAS unsigned char* ldsl = (LAS unsigned char*)(uintptr_t)(unsigned)(uintptr_t)lds;
  float m_reg = -1e30f, l_reg = 0.f; f32x16 o[8] = {}; bf16x8 qr[8];
  const bf16* Qw = Qb + (long)(wid * QBLK + r32) * LDQ + hi * 8;
#pragma unroll
  for (int d0 = 0; d0 < 8; ++d0) qr[d0] = *reinterpret_cast<const bf16x8*>(Qw + d0 * 16);
  const int koff = (tid >> 4) * LDK + (((tid & 15) ^ ((tid >> 4) & 7)) * 8);
  int voff; { const int kk0 = 8 * (tid >> 7) + ((tid >> 2) & 7), k0 = (kk0 & ~0xC) | ((kk0 & 4) << 1) | ((kk0 & 8) >> 1); voff = k0 * LDK + 32 * ((tid >> 5) & 3) + 8 * (tid & 3); }
  const int vb0 = (int)(uintptr_t)V_lds + v_rd_base(lane);
#define A2_STAGE(j_, b_) do { const bf16* kp = Kh + (long)(j_) * 64 * LDK + koff; const bf16* vp = Vh + (long)(j_) * 64 * LDK + voff; \
    _Pragma("unroll") for (int i = 0; i < 2; ++i) __builtin_amdgcn_global_load_lds((const unsigned*)(kp + (long)i * 32 * LDK), (LAS unsigned*)(ldsl + (b_) * SHM2_K + wid * 1024 + i * 8192), 16, 0, 0); \
    _Pragma("unroll") for (int i = 0; i < 4; ++i) __builtin_amdgcn_global_load_lds((const unsigned*)(vp + (long)(i & 1) * 32 * LDK + (i >> 1) * 128), (LAS unsigned*)(ldsl + 2 * SHM2_K + (b_) * SHM2_V + wid * 1024 + i * 8192), 16, 0, 0); } while (0)
  A2_STAGE(0, 0);
  f32x16 p0, p1; float mn, al; bf16x8 pa0, pa1, pa2, pa3;
  for (int j = 0; j < NT; ++j) {
    const int b = j & 1;
    asm volatile("s_waitcnt vmcnt(0) lgkmcnt(0)\n\ts_barrier" ::: "memory");
    if (j + 1 < NT) A2_STAGE(j + 1, b ^ 1);
    qkt(p0, p1, K_lds + b * SHM2_K, qr, r32, hi);
    partialSM(p0, p1, m_reg, mn, al, false, 0, 0, hi);
    finishSM(p0, p1, al, l_reg, pa0, pa1, pa2, pa3);
    if (__any(al < 1.f)) { if (hi == 0) al_l[r32] = al; asm volatile("s_waitcnt lgkmcnt(0)" ::: "memory");
#pragma unroll
      for (int d = 0; d < 8; ++d)
#pragma unroll
        for (int r = 0; r < 16; ++r) o[d][r] *= al_l[crow(r, hi)]; }
    const int vb = vb0 + b * (int)SHM2_V;
    pv_one<0>(o[0], vb, pa0, pa1, pa2, pa3); pv_one<1>(o[1], vb, pa0, pa1, pa2, pa3); pv_one<2>(o[2], vb, pa0, pa1, pa2, pa3); pv_one<3>(o[3], vb, pa0, pa1, pa2, pa3);
    pv_one<0>(o[4], vb + 16384, pa0, pa1, pa2, pa3); pv_one<1>(o[5], vb + 16384, pa0, pa1, pa2, pa3); pv_one<2>(o[6], vb + 16384, pa0, pa1, pa2, pa3); pv_one<3>(o[7], vb + 16384, pa0, pa1, pa2, pa3);
  }
  if (hi == 0) li_l[r32] = l_reg; asm volatile("s_waitcnt lgkmcnt(0)" ::: "memory");
  float rli[16];
#pragma unroll
  for (int r = 0; r < 16; ++r) rli[r] = __builtin_amdgcn_rcpf(li_l[crow(r, hi)]);
  bf16* Ow = Ob + (long)(wid * QBLK) * LDO;
#pragma unroll
  for (int r = 0; r < 16; ++r) { const int orow = crow(r, hi);
#pragma unroll
    for (int d0 = 0; d0 < 8; ++d0) Ow[(long)orow * LDO + d0 * 32 + r32] = (bf16)f2bf(o[d0][r] * rli[r]); }
  asm volatile("s_waitcnt vmcnt(0) lgkmcnt(0)\n\ts_barrier" ::: "memory");
#undef A2_STAGE
}

template <int LDQ, int LDK, int LDO, bool BAND, bool SINK>
__device__ __forceinline__ void attn3_body(const bf16* __restrict__ Qb, const bf16* __restrict__ Kh, const bf16* __restrict__ Vh, bf16* __restrict__ Ob,
                                           int NT, int nctx, int latrow0, int klat0, int q0, float sink, char* lds, int wave) {
  const int tid = pg8::tid_of(wave); const int wid = __builtin_amdgcn_readfirstlane(tid >> 6), lane = tid & 63, r32 = lane & 31, hi = lane >> 5;
  char* K_lds = lds; char* V_lds = lds + 2 * SHM2_K;
  float* ws = (float*)(lds + 2 * SHM2_K + 2 * SHM2_V) + wid * 64; float* li_l = ws; float* al_l = ws + 32;
  LAS unsigned char* ldsl = (LAS unsigned char*)(uintptr_t)(unsigned)(uintptr_t)lds;
  float m_reg = SINK ? sink : -1e30f, l_reg = SINK ? 1.f : 0.f; f32x16 o[4] = {}; bf16x8 qr[8];
  const bf16* Qw = Qb + (long)(wid * QBLK + r32) * LDQ + hi * 8;
#pragma unroll
  for (int d0 = 0; d0 < 8; ++d0) qr[d0] = *reinterpret_cast<const bf16x8*>(Qw + d0 * 16);
  const int qidx = q0 + wid * QBLK + r32, qlo = q0 + wid * QBLK;
  const int koff = (tid >> 4) * LDK + (((tid & 15) ^ ((tid >> 4) & 7)) * 8);
  int voff; { const int kk0 = 8 * (tid >> 7) + ((tid >> 2) & 7), k0 = (kk0 & ~0xC) | ((kk0 & 4) << 1) | ((kk0 & 8) >> 1); voff = k0 * LDK + 32 * ((tid >> 5) & 3) + 8 * (tid & 3); }
  const int vb0 = (int)(uintptr_t)V_lds + v_rd_base(lane);
#define A3_ROW(j_) ((j_) < nctx ? 64 * (j_) : latrow0 + 64 * ((j_) - nctx))
#define A3_STAGE(j_, b_) do { const long r0_ = A3_ROW(j_); const bf16* kp = Kh + r0_ * LDK + koff; const bf16* vp = Vh + r0_ * LDK + voff; \
    _Pragma("unroll") for (int i = 0; i < 2; ++i) __builtin_amdgcn_global_load_lds((const unsigned*)(kp + (long)i * 32 * LDK), (LAS unsigned*)(ldsl + (b_) * SHM2_K + wid * 1024 + i * 8192), 16, 0, 0); \
    _Pragma("unroll") for (int i = 0; i < 2; ++i) __builtin_amdgcn_global_load_lds((const unsigned*)(vp + (long)i * 32 * LDK), (LAS unsigned*)(ldsl + 2 * SHM2_K + (b_) * SHM2_V + wid * 1024 + i * 8192), 16, 0, 0); } while (0)
  A3_STAGE(0, 0);
  f32x16 p0, p1; float mn, al; bf16x8 pa0, pa1, pa2, pa3;
  for (int j = 0; j < NT; ++j) {
    const int b = j & 1;
    asm volatile("s_waitcnt vmcnt(0) lgkmcnt(0)\n\ts_barrier" ::: "memory");
    if (j + 1 < NT) A3_STAGE(j + 1, b ^ 1);
    const bool band = BAND && j >= nctx; const int kq = klat0 + 64 * (j - nctx);
    if (!band || (kq + 63 >= qlo - 128 && kq <= qlo + QBLK - 1 + 128)) {
      qkt(p0, p1, K_lds + b * SHM2_K, qr, r32, hi);
      partialSM(p0, p1, m_reg, mn, al, band, kq, qidx, hi);
      finishSM(p0, p1, al, l_reg, pa0, pa1, pa2, pa3);
      if (__any(al < 1.f)) { if (hi == 0) al_l[r32] = al; asm volatile("s_waitcnt lgkmcnt(0)" ::: "memory");
#pragma unroll
        for (int d = 0; d < 4; ++d)
#pragma unroll
          for (int r = 0; r < 16; ++r) o[d][r] *= al_l[crow(r, hi)]; }
      const int vb = vb0 + b * (int)SHM2_V;
      pv_one<0>(o[0], vb, pa0, pa1, pa2, pa3); pv_one<1>(o[1], vb, pa0, pa1, pa2, pa3); pv_one<2>(o[2], vb, pa0, pa1, pa2, pa3); pv_one<3>(o[3], vb, pa0, pa1, pa2, pa3);
    }
  }
  if (hi == 0) li_l[r32] = l_reg; asm volatile("s_waitcnt lgkmcnt(0)" ::: "memory");
  float rli[16];
#pragma unroll
  for (int r = 0; r < 16; ++r) rli[r] = __builtin_amdgcn_rcpf(li_l[crow(r, hi)]);
  bf16* Ow = Ob + (long)(wid * QBLK) * LDO;
#pragma unroll
  for (int r = 0; r < 16; ++r) { const int orow = crow(r, hi);
#pragma unroll
    for (int d0 = 0; d0 < 4; ++d0) Ow[(long)orow * LDO + d0 * 32 + r32] = (bf16)f2bf(o[d0][r] * rli[r]); }
  asm volatile("s_waitcnt vmcnt(0) lgkmcnt(0)\n\ts_barrier" ::: "memory");
#undef A3_STAGE
#undef A3_ROW
}
}
__device__ __forceinline__ void ga_attn_phase(Frame& F0, const Args& a, int jg, int need_ctx, char* lds) {
    Frame F = F0; F.tid = opaque_tid(F0.wave); F.lane = F.tid & 63;
    const bf16* proj = (const bf16*)(a.ws + WS_PROJ); bf16* ob = (bf16*)(a.ws + WS_OBUF);
    const float* sinkp = a.in[12] + jg * 16;
    const int nlat = NB * 16 * 16, nunits = nlat + (need_ctx ? NB * 16 : 0);
    for (int u = F.bid; u < nunits; u += F.G) {
        int head, b, qrow, nt, latrow0, klat0, q0;
        if (u < nlat) { const int w = u & 255, x = w & 7, i = w >> 3; head = (x >> 1) * 4 + (i & 3); const int qt = (x & 1) * 8 + (i >> 2); b = u >> 8;
            const int ks = (qt * 256 - 128 < 0) ? 0 : qt * 256 - 128, ke = (qt * 256 + 384 > SEQ) ? SEQ : qt * 256 + 384;
            qrow = CTXL + qt * 256; nt = 4 + (ke - ks) / 64; latrow0 = CTXL + ks; klat0 = ks; q0 = qt * 256; }
        else { const int uu = u - nlat; head = uu & 15; b = uu >> 4; qrow = 0; nt = 4; latrow0 = 0; klat0 = 0; q0 = 0; }
        const int kv = head >> 2; const size_t rb = (size_t)b * RPB;
        att::attn3_body<GA_N, GA_N, DM, true, true>(proj + (rb + qrow) * GA_N + head * 128, proj + rb * GA_N + 2048 + kv * 128, proj + rb * GA_N + 2560 + kv * 128,
            ob + (rb + qrow) * DM + head * 128, nt, 4, latrow0, klat0, q0, sinkp[head], lds, F.wave);
    }
}
__device__ __forceinline__ void df_attn_phase(Frame& F0, const Args& a, char* lds) {
    Frame F = F0; F.tid = opaque_tid(F0.wave); F.lane = F.tid & 63;
    const bf16* proj = (const bf16*)(a.ws + WS_PROJ); bf16* ob = (bf16*)(a.ws + WS_OBUF);
    const int nlat = NB * 16 * 16, nunits = nlat + NB * 16;
    for (int u = F.bid; u < nunits; u += F.G) {
        int qt, combo, b, nt; size_t qrow;
        if (u < nlat) { const int w = u & 255, i = w >> 3; qt = i >> 1; combo = (w & 7) * 2 + (i & 1); b = u >> 8; nt = RPB / 64; qrow = (size_t)b * RPB + CTXL + qt * 256; }
        else { const int uu = u - nlat; combo = uu & 15; b = uu >> 4; nt = CTXL / 64; qrow = (size_t)b * RPB; }
        const int hh = combo >> 1, r = combo & 1;
        const size_t rb = (size_t)b * RPB;
        att::attn2_body<DF_N, DF_N, 4096>(proj + qrow * DF_N + (hh * 2 + r) * 128, proj + rb * DF_N + 2048 + (hh * 2 + r) * 128, proj + rb * DF_N + 4096 + hh * 256,
            ob + qrow * 4096 + r * 2048 + hh * 256, nt, lds, F.wave);
    }
}
namespace rt {
__device__ __forceinline__ unsigned off_a(unsigned row, unsigned ch) { return 2048u * (row >> 3) + 512u * (ch >> 2) + 64u * (row & 7) + 16u * ((ch & 3) ^ ((row >> 2) & 3)); }
__device__ __forceinline__ unsigned rr_base(unsigned lane, unsigned e) { return off_a(lane & 31, 2 * e + (lane >> 5)); }
__device__ __forceinline__ unsigned tr_base(unsigned lane, unsigned t) {
    const unsigned h = lane >> 5, blk = (lane >> 4) & 1, q = (lane & 15) >> 2, p = lane & 3;
    return off_a(8 * h + 4 * t + q, 2 * blk + (p >> 1)) + 8 * (p & 1);
}
template <int OFF> __device__ __forceinline__ s16x4 trd(unsigned addr) { s16x4 r; asm volatile("ds_read_b64_tr_b16 %0, %1 offset:%2" : "=&v"(r) : "v"(addr), "i"(OFF) : "memory"); return r; }
template <int OFF> __device__ __forceinline__ bf16x8 rrd(unsigned addr) { bf16x8 r; asm volatile("ds_read_b128 %0, %1 offset:%2" : "=&v"(r) : "v"(addr), "i"(OFF) : "memory"); return r; }
__device__ __forceinline__ int crow(int r, int hi) { return (r & 3) + 8 * (r >> 2) + 4 * hi; }
#define PK8(L, H) (bf16x8){L[0], L[1], L[2], L[3], H[0], H[1], H[2], H[3]}
constexpr int RQ = 0, RK = 32768, RV = 65536, RS = 98304;
template <int SP> __device__ __forceinline__ void mm_rr(f32x16& c0, f32x16& c1, unsigned aE, unsigned aO, unsigned bE, unsigned bO) {
    const bf16x8 a0 = rrd<512 * SP>(aE), a1 = rrd<512 * SP>(aO);
    const bf16x8 b00 = rrd<512 * SP>(bE), b01 = rrd<512 * SP>(bO), b10 = rrd<512 * SP + 8192>(bE), b11 = rrd<512 * SP + 8192>(bO);
    asm volatile("s_waitcnt lgkmcnt(0)" ::: "memory"); SBAR();
    c0 = __builtin_amdgcn_mfma_f32_32x32x16_bf16(a0, b00, c0, 0, 0, 0); c1 = __builtin_amdgcn_mfma_f32_32x32x16_bf16(a0, b10, c1, 0, 0, 0);
    c0 = __builtin_amdgcn_mfma_f32_32x32x16_bf16(a1, b01, c0, 0, 0, 0); c1 = __builtin_amdgcn_mfma_f32_32x32x16_bf16(a1, b11, c1, 0, 0, 0);
    asm volatile("" : "+v"(c0), "+v"(c1));
}
template <int KS> __device__ __forceinline__ void mm_tt(f32x16& c0, f32x16& c1, unsigned aT0, unsigned aT1, unsigned bT0, unsigned bT1) {
    const s16x4 a0 = trd<4096 * KS>(aT0), a1 = trd<4096 * KS>(aT1);
    const s16x4 b00 = trd<4096 * KS>(bT0), b01 = trd<4096 * KS>(bT1), b10 = trd<4096 * KS + 512>(bT0), b11 = trd<4096 * KS + 512>(bT1);
    asm volatile("s_waitcnt lgkmcnt(0)" ::: "memory"); SBAR();
    const bf16x8 af = PK8(a0, a1);
    c0 = __builtin_amdgcn_mfma_f32_32x32x16_bf16(af, PK8(b00, b01), c0, 0, 0, 0); c1 = __builtin_amdgcn_mfma_f32_32x32x16_bf16(af, PK8(b10, b11), c1, 0, 0, 0);
    asm volatile("" : "+v"(c0), "+v"(c1));
}
template <int KS> __device__ __forceinline__ void mm_rt(f32x16& c0, f32x16& c1, unsigned aB, unsigned bT0, unsigned bT1) {
    const bf16x8 a0 = rrd<512 * (KS >> 1)>(aB);
    const s16x4 b00 = trd<4096 * KS>(bT0), b01 = trd<4096 * KS>(bT1), b10 = trd<4096 * KS + 512>(bT0), b11 = trd<4096 * KS + 512>(bT1);
    asm volatile("s_waitcnt lgkmcnt(0)" ::: "memory"); SBAR();
    c0 = __builtin_amdgcn_mfma_f32_32x32x16_bf16(a0, PK8(b00, b01), c0, 0, 0, 0); c1 = __builtin_amdgcn_mfma_f32_32x32x16_bf16(a0, PK8(b10, b11), c1, 0, 0, 0);
    asm volatile("" : "+v"(c0), "+v"(c1));
}
#define RT_BAR(NV) do { if (PROBE & 4) asm volatile("s_waitcnt vmcnt(" #NV ") lgkmcnt(0)" ::: "memory"); else asm volatile("s_waitcnt vmcnt(" #NV ") lgkmcnt(0)\n\ts_barrier" ::: "memory"); } while (0)
#define RT_BARL() do { if (PROBE & 4) asm volatile("s_waitcnt lgkmcnt(0)" ::: "memory"); else asm volatile("s_waitcnt lgkmcnt(0)\n\ts_barrier" ::: "memory"); } while (0)
template <int PROBE> __device__ __forceinline__ void scan_unit(const bf16* __restrict__ proj, const bf16* __restrict__ kbw, bf16* __restrict__ outp, int b, int hh, int dir, int sl, float lg2, unsigned ldsb, char* lds, int wave) {
    const int tid = pg8::tid_of(wave);
    const int wid = __builtin_amdgcn_readfirstlane(tid >> 6), wr = wid >> 1, wc = wid & 1;
    const size_t rb = (size_t)b * RPB;
    const int qcol = hh * 256, vcol = 4096 + hh * 512 + sl * 128, ocol = hh * 512 + sl * 128;
    const bf16* kptr = dir == 0 ? proj + 2048 + hh * 256 : kbw + hh * 256;
    const int ldk = dir == 0 ? RT_N : DM;
    f32x16 S[2][2];
#pragma unroll
    for (int i = 0; i < 2; ++i)
#pragma unroll
        for (int t = 0; t < 2; ++t) S[i][t] = f32x16{};
    const float g128 = exp2f(lg2 * 128.f);
    const unsigned oW = 8192u * wr, oC = 16384u * wc;
    const unsigned cW = 512u * wr, cC = 1024u * wc;
    int dma_off, dma_offk;
    { const int ln = tid & 63, rowb = 8 * (wid >> 1) + ((ln >> 2) & 7), ch = 4 * (2 * (wid & 1) + (ln >> 5)) + ((ln & 3) ^ ((rowb >> 2) & 3)); dma_off = rowb * RT_N + ch * 8; dma_offk = rowb * ldk + ch * 8; }
    LAS unsigned char* ldsl = (LAS unsigned char*)(uintptr_t)ldsb;
#define RT_CHUNK_ROW(ci_) (rb + (size_t)(dir == 0 ? (ci_) : ((ci_) == 0 ? 1 : ((ci_) == 1 ? 0 : 35 - (ci_)))) * 128)
#define RT_DMA(REG, gp_, ld_, off_) if (!(PROBE & 2)) _Pragma("unroll") for (int i = 0; i < 4; ++i) __builtin_amdgcn_global_load_lds((const unsigned*)((gp_) + (size_t)i * 32 * (ld_) + (off_)), (LAS unsigned*)(ldsl + (REG) + wid * 1024 + i * 8192), 16, 0, 0)
#define RT_STORES(hd_) { int tq = tid; asm volatile("" : "+v"(tq)); const int r32_ = tq & 31, hi_ = (tq >> 5) & 1; _Pragma("unroll") for (int t = 0; t < 2; ++t) { const unsigned dv = (2 * wc + t) * 32 + r32_; \
        _Pragma("unroll") for (int g = 0; g < 4; ++g) { v2u w; w.x = cvtpk_s(S[hd_][t][4 * g + 0], S[hd_][t][4 * g + 1]); w.y = cvtpk_s(S[hd_][t][4 * g + 2], S[hd_][t][4 * g + 3]); \
            *(v2u*)(lds + RS + off_a(dv, wr * 4 + g) + 8 * hi_) = w; } } }
#define RT_PO() do { unsigned rE = rE0, rO = rO0; asm volatile("" : "+v"(rE), "+v"(rO)); \
        { const unsigned aE = rE + RK + oW, aO = rO + RK + oW, bE = rE + RQ + oC, bO = rO + RQ + oC; \
          mm_rr<0>(P0, P1, aE, aO, bE, bO); mm_rr<1>(P0, P1, aE, aO, bE, bO); mm_rr<2>(P0, P1, aE, aO, bE, bO); mm_rr<3>(P0, P1, aE, aO, bE, bO); } \
        { const unsigned aE = rE + RQ + oW, aO = rO + RQ + oW, bE = rE + RS + oC, bO = rO + RS + oC; \
          mm_rr<0>(O0, O1, aE, aO, bE, bO); mm_rr<1>(O0, O1, aE, aO, bE, bO); mm_rr<2>(O0, O1, aE, aO, bE, bO); mm_rr<3>(O0, O1, aE, aO, bE, bO); } } while (0)
#define RT_SUPD(hd_) do { unsigned tT0 = tT00, tT1 = tT10; asm volatile("" : "+v"(tT0), "+v"(tT1)); const unsigned a0 = tT0 + RK + cW, a1 = tT1 + RK + cW, b0 = tT0 + RV + cC, b1 = tT1 + RV + cC; \
          mm_tt<0>(S[hd_][0], S[hd_][1], a0, a1, b0, b1); mm_tt<1>(S[hd_][0], S[hd_][1], a0, a1, b0, b1); mm_tt<2>(S[hd_][0], S[hd_][1], a0, a1, b0, b1); mm_tt<3>(S[hd_][0], S[hd_][1], a0, a1, b0, b1); \
          mm_tt<4>(S[hd_][0], S[hd_][1], a0, a1, b0, b1); mm_tt<5>(S[hd_][0], S[hd_][1], a0, a1, b0, b1); mm_tt<6>(S[hd_][0], S[hd_][1], a0, a1, b0, b1); mm_tt<7>(S[hd_][0], S[hd_][1], a0, a1, b0, b1); } while (0)
    { const size_t r0 = RT_CHUNK_ROW(0); RT_DMA(RQ, proj + r0 * RT_N + qcol, RT_N, dma_off); RT_DMA(RK, kptr + r0 * ldk, ldk, dma_offk); }
    for (int ci = 0; ci < 34; ++ci) {
        const size_t row0 = RT_CHUNK_ROW(ci);
        int tz = tid; asm volatile("" : "+v"(tz));
        const int lanez = tz & 63, r32 = lanez & 31, hi = lanez >> 5;
        const unsigned rE0 = ldsb + rr_base(lanez, 0), rO0 = ldsb + rr_base(lanez, 1), tT00 = ldsb + tr_base(lanez, 0), tT10 = ldsb + tr_base(lanez, 1);
        const int ib = wr * 32 + 4 * hi;
#pragma unroll
        for (int i = 0; i < 2; ++i)
#pragma unroll
            for (int t = 0; t < 2; ++t) S[i][t] *= g128;
        const bf16* gbase = proj + row0 * RT_N; const bf16* kbase = kptr + row0 * ldk;
        f32x16 P0 = f32x16{}, P1 = f32x16{}, O0 = f32x16{}, O1 = f32x16{};
        RT_DMA(RV, gbase + vcol, RT_N, dma_off);
        RT_STORES(0);
        RT_BAR(4);
        RT_PO();
        RT_BAR(0);
        RT_DMA(RQ, gbase + qcol + 128, RT_N, dma_off);
        RT_SUPD(0);
        RT_BARL();
        RT_DMA(RK, kbase + 128, ldk, dma_offk);
        RT_STORES(1);
        RT_BAR(0);
        RT_PO();
        RT_BARL();
        if (ci + 1 < 34) { const size_t rn = RT_CHUNK_ROW(ci + 1); RT_DMA(RQ, proj + rn * RT_N + qcol, RT_N, dma_off); }
        RT_SUPD(1);
        RT_BARL();
        if (ci + 1 < 34) { const size_t rn = RT_CHUNK_ROW(ci + 1); RT_DMA(RK, kptr + rn * ldk, ldk, dma_offk); }
#pragma unroll
        for (int t = 0; t < 2; ++t) { const int i = (2 * wc + t) * 32 + r32; int dji = ib - i; if (dir) dji = -dji;
#pragma unroll
            for (int g = 0; g < 4; ++g) { float v[4];
#pragma unroll
                for (int e = 0; e < 4; ++e) { const int je = dir == 0 ? (8 * g + e) : -(8 * g + e); const bool keep = (dji + je) <= 0; const float pv = t == 0 ? P0[4 * g + e] : P1[4 * g + e]; v[e] = keep ? pv : 0.f; }
                v2u w; w.x = cvtpk_s(v[0], v[1]); w.y = cvtpk_s(v[2], v[3]);
                *(v2u*)(lds + RS + off_a(i, wr * 4 + g) + 8 * hi) = w; } }
        RT_BARL();
        { unsigned rE = rE0, rO = rO0, tT0 = tT00, tT1 = tT10; asm volatile("" : "+v"(rE), "+v"(rO), "+v"(tT0), "+v"(tT1));
          const unsigned aE = rE + RS + oW, aO = rO + RS + oW, b0 = tT0 + RV + cC, b1 = tT1 + RV + cC;
          mm_rt<0>(O0, O1, aE, b0, b1); mm_rt<1>(O0, O1, aO, b0, b1); mm_rt<2>(O0, O1, aE, b0, b1); mm_rt<3>(O0, O1, aO, b0, b1);
          mm_rt<4>(O0, O1, aE, b0, b1); mm_rt<5>(O0, O1, aO, b0, b1); mm_rt<6>(O0, O1, aE, b0, b1); mm_rt<7>(O0, O1, aO, b0, b1); }
        GAS bf16* obase = (GAS bf16*)(outp + row0 * RT_V + ocol + (wr * 32 + 4 * hi) * RT_V + wc * 64 + r32); asm volatile("" : "+v"(obase));
#pragma unroll
        for (int r = 0; r < 16; ++r) { const int iz = ib + (r & 3) + 8 * (r >> 2);
            const float mi = __builtin_amdgcn_exp2f(lg2 * (float)(dir == 0 ? iz - 127 : -iz));
            if (PROBE & 1) { asm volatile("" :: "v"(O0[r] * mi), "v"(O1[r] * mi)); } else {
            obase[(r & 3) * RT_V + (r >> 2) * 8 * RT_V] = (bf16)f2bf(O0[r] * mi); obase[(r & 3) * RT_V + (r >> 2) * 8 * RT_V + 32] = (bf16)f2bf(O1[r] * mi); } }
        RT_BARL();
    }
    asm volatile("s_waitcnt vmcnt(0)" ::: "memory");
}
#undef RT_BAR
#undef RT_BARL
#undef RT_CHUNK_ROW
#undef RT_DMA
#undef RT_STORES
#undef RT_PO
#undef RT_SUPD
#undef PK8
}
template <int PROBE> __device__ __forceinline__ void rt_scan_phase(Frame& F0, const Args& a, char* lds) {
    Frame F = F0; F.tid = opaque_tid(F0.wave); F.lane = F.tid & 63;
    const bf16* proj = (const bf16*)(a.ws + WS_PROJ);
    for (int u0 = F.bid; u0 < NB * 8 * 2 * 4; u0 += F.G) {
        const int w_ = u0 & 255, x_ = w_ & 7, i_ = w_ >> 3; const int u = (u0 & ~255) | ((((i_ >> 2) * 8 + x_) << 2) | (i_ & 3));
        const int sl = u & 3, dir = (u >> 2) & 1, hh = (u >> 3) & 7, b = u >> 6;
        const float x = a.in[16][dir * 8 + hh];
        const float lg2 = -log2f(1.f + expf(-x));
        bf16* outp = (bf16*)(a.ws + (dir == 0 ? WS_OBUF : WS_XBUF));
        rt::scan_unit<PROBE>(proj, (const bf16*)a.out  , outp, b, hh, dir, sl, lg2, (unsigned)(uintptr_t)lds, lds, F.wave);
    }
}
constexpr int NPHASE = 42;
#ifndef PHMASK
#define PHMASK 0xffff
#endif
#define EN(k) ((PHMASK >> (k)) & 1)
#ifndef REPMASK
#define REPMASK 0
#endif
#ifndef REPCNT
#define REPCNT 1
#endif
#define NREP(k) (((REPMASK >> (k)) & 1) ? 1 + REPCNT : 1)
#ifndef GEMM_ALIGN
#define GEMM_ALIGN true
#endif
#ifndef GEMM_SP2
#define GEMM_SP2 true
#endif
#ifndef SCANPROBE
#define SCANPROBE 0
#endif
#ifndef MK_PER_PHASE
#define MK_PER_PHASE 0
#endif
#ifndef NVGPR_ATTR
#define NVGPR_ATTR
#endif
#ifndef LB_ATTR
#define LB_ATTR __launch_bounds__(NTHR, 2)
#endif
__global__ void LB_ATTR NVGPR_ATTR mega_fwd(Args args) {
    extern __shared__ __attribute__((aligned(16))) unsigned char lds[];
    Frame F;
    F.lds = (LAS unsigned char*)lds;
    F.MISC = (volatile LAS unsigned*)(F.lds + MISC_OFF);
    F.tid = threadIdx.x; F.lane = F.tid & 63; F.wave = __builtin_amdgcn_readfirstlane(F.tid >> 6);
    F.G = gridDim.x; F.bid = blockIdx.x; F.gw = F.bid * NWAVES + F.wave; F.NGW = F.G * NWAVES;
    unsigned char* ws = args.ws;
    F.ctl = (gu32*)(ws + WS_CTL);
    for (int u = F.tid; u < (LDS_BYTES - RING_BYTES) / 4; u += NTHR) ((LAS unsigned*)(F.lds + RING_BYTES))[u] = 0u;
    __syncthreads();
    XcdBarrier bar; bar.bar = (unsigned*)(F.ctl + CW_BAR); bar.x = 0; bar.st = nullptr; bar.wv = F.wave;
    if (!MK_PER_PHASE) bar = xcd_barrier_post((unsigned*)(F.ctl + CW_BAR), F.MISC + 8);
    const int lo = args.ph_lo, hi = args.ph_hi;
#define IN(k) (lo <= (k) && (k) < hi)
#ifndef BARREP
#define BARREP 1
#endif
#define SEAM(k) do { if (IN(k) && IN((k) + 1)) { for (int br = 0; br < BARREP; ++br) xcd_barrier(bar); } } while (0)
    const float* modbase = (const float*)(ws + WS_MOD);
    pg8::bf16_t* hres = (pg8::bf16_t*)(ws + WS_H);
    bf16* abuf = (bf16*)(ws + WS_ABUF); bf16* proj = (bf16*)(ws + WS_PROJ); bf16* obuf = (bf16*)(ws + WS_OBUF);

    if (IN(0)) { for (int rep = 0; rep < NREP(0); ++rep) p0_prologue(F, args); } SEAM(0);
    if (IN(1)) { if (EN(1)) p0b_modfinal(F, args); } SEAM(1);

#define GEMM_QK(Aptr, Btptr, Nn, Optr, nkt, gqp, gkp, Gq) do { if (EN(3)) for (int rep = 0; rep < NREP(3); ++rep) { pg8::Gemm g{(const pg8::bf16_t*)(Aptr), (const pg8::bf16_t*)(Btptr), MROWS, (Nn), DM}; \
        pg8::StaticOrder S; S.init(68, (Nn), DM, (Gq), F.bid, 0, 0); pg8::EpiQK E{(pg8::bf16_t*)(Optr), (Nn), 8, (nkt), (gqp), (gkp), (const float*)(ws + WS_ROPE), 0.08838834764831845f, (PG8_LAS float*)(F.lds + RING_BYTES + 1024)}; \
        pg8::gemm_phase<pg8::EpiQK, pg8::StaticOrder, GEMM_ALIGN, GEMM_SP2>(F.lds, g, S, E, F.wave); } } while (0)
#define GEMM_RT(Aptr, Btptr, Optr, KBptr) do { if (EN(3)) for (int rep = 0; rep < NREP(3); ++rep) { pg8::Gemm g{(const pg8::bf16_t*)(Aptr), (const pg8::bf16_t*)(Btptr), MROWS, RT_N, DM}; \
        pg8::StaticOrder S; S.init(68, RT_N, DM, F.G, F.bid, 0, 0); pg8::EpiRT E{(pg8::bf16_t*)(Optr), RT_N, (const float*)(ws + WS_ROPE_RT), (pg8::bf16_t*)(KBptr), args.in[16]}; \
        pg8::gemm_phase<pg8::EpiRT, pg8::StaticOrder, GEMM_ALIGN, GEMM_SP2>(F.lds, g, S, E, F.wave); } } while (0)
#define GEMM_FFNIN(Aptr, Btptr, Optr, nMt, latonly, LL) do { if (EN(3)) for (int rep = 0; rep < NREP(3); ++rep) { pg8::Gemm g{(const pg8::bf16_t*)(Aptr), (const pg8::bf16_t*)(Btptr), MROWS, DFF2, DM}; \
        pg8::StaticOrder S; S.init((nMt), DFF2, DM, F.G, F.bid, (latonly), 0); pg8::EpiConvGate E{(pg8::bf16_t*)obuf, (pg8::bf16_t*)(Optr), args.in[8] + (size_t)(LL) * 3 * DFF2, args.in[9] + (size_t)(LL) * DFF2}; \
        pg8::gemm_phase<pg8::EpiConvGate, pg8::StaticOrder, GEMM_ALIGN, GEMM_SP2>(F.lds, g, S, E, F.wave); } } while (0)
#define GEMM_RES(Aptr, Btptr, Kk, gateptr, outptr, nMt, latonly, xsrcp) do { if (EN(11)) for (int rep = 0; rep < NREP(11); ++rep) { pg8::Gemm g{(const pg8::bf16_t*)(Aptr), (const pg8::bf16_t*)(Btptr), MROWS, DM, (Kk)}; \
        pg8::StaticOrder S; S.init(64, DM, (Kk), F.G, F.bid, 1, (nMt) == 68); pg8::EpiResGate E{hres, (gateptr), (outptr), rep ? (float*)(ws + WS_PROJ) : (float*)nullptr, (pg8::bf16_t*)(ws + WS_XBUF), (xsrcp)}; \
        pg8::gemm_phase<pg8::EpiResGate, pg8::StaticOrder, GEMM_ALIGN, GEMM_SP2>(F.lds, g, S, E, F.wave); } } while (0)

#define LAYER(L, KIND, JX, LAST) do { \
    constexpr int PB = 2 + 10 * (L); const float* modl = modbase + (size_t)(L) * 5 * MODW; \
    if (IN(PB + 0)) { for (int rep = 0; rep < NREP(2); ++rep) norm_mod_phase(F, args, (L), 0, 0, (L) > 0 ? modbase + (size_t)((L) - 1) * 5 * MODW + 4 * MODW + 5 * DM : (const float*)nullptr, (L) == 0 ? args.in[0] : (const float*)nullptr, (L) == 0 ? args.in[2] : (const float*)nullptr); } SEAM(PB + 0); \
    if (IN(PB + 1)) { \
        if (KIND == 0) { const int gq_ = ((L) == 0 && F.G == PART_G) ? PART_GEMM : F.G; \
            if (F.bid < gq_) { GEMM_QK(abuf, ws + WS_W_GA_QKV + (size_t)(JX) * GA_N * DM * 2, GA_N, proj, 2, args.in[13] + (JX) * 256, args.in[13] + (JX) * 256 + 128, gq_); \
                if ((L) == 0 && pg8::tid_of(F.wave) == 0) (void)xb_add((unsigned*)F.ctl + CW_DQ_DONE, 1u); } \
            else dq_work(F, args, true); } \
        else if (KIND == 1) GEMM_RT(abuf, ws + WS_W_RT_IN, proj, args.out); \
        else GEMM_QK(abuf, ws + WS_W_DF_QKV, DF_N, proj, 8, args.in[21], args.in[21] + 128, F.G); } SEAM(PB + 1); \
    if (IN(PB + 3)) { \
        if (KIND == 0) { if (EN(6)) for (int rep = 0; rep < NREP(6); ++rep) ga_attn_phase(F, args, (JX), !(LAST), (char*)lds); } \
        else if (KIND == 1) { if (EN(7)) { rt_scan_phase<0>(F, args, (char*)lds); for (int rep = 1; rep < NREP(7); ++rep) rt_scan_phase<SCANPROBE>(F, args, (char*)lds); } } \
        else { if (EN(8)) for (int rep = 0; rep < NREP(8); ++rep) df_attn_phase(F, args, (char*)lds); } } SEAM(PB + 3); \
    if (IN(PB + 4)) { \
        if (KIND == 1) { if (EN(9)) rt_combine_phase(F, args); } \
        else if (KIND == 2) { if (EN(10)) df_combine_phase(F, args, 0.8f - 0.6f * 0.5488116360940264f); } } SEAM(PB + 4); \
    if (IN(PB + 5)) { \
        if (KIND == 0) GEMM_RES(obuf, ws + WS_W_GA_WO + (size_t)(JX) * DM * DM * 2, DM, modl + 2 * DM, (float*)nullptr, (LAST) ? 64 : 68, (LAST), (L) == 0 ? args.in[0] : (const float*)nullptr); \
        else if (KIND == 1) GEMM_RES(obuf, ws + WS_W_RT_WO, RT_V, modl + 2 * DM, (float*)nullptr, 68, 0, (const float*)nullptr); \
        else GEMM_RES(abuf, ws + WS_W_DF_WO, DM, modl + 2 * DM, (float*)nullptr, 68, 0, (const float*)nullptr); } SEAM(PB + 5); \
    if (IN(PB + 6)) { if ((L) == 0) dq_work(F, args, false); for (int rep = 0; rep < NREP(2); ++rep) norm_mod_phase(F, args, (L), 1, (LAST), (LAST) ? (const float*)nullptr : modl + 4 * MODW + 2 * DM, (const float*)nullptr, (L) == 0 ? args.in[2] : (const float*)nullptr); } SEAM(PB + 6); \
    if (IN(PB + 7)) { GEMM_FFNIN(abuf, ws + WS_W_FFN_IN + (size_t)(L) * DFF2 * DM * 2, proj, (LAST) ? 64 : 68, (LAST), (L)); } SEAM(PB + 7); \
    if (IN(PB + 8)) { conv_fix_phase(F, args, (L), (LAST)); } SEAM(PB + 8); \
    if (IN(PB + 9)) { GEMM_RES(obuf, ws + WS_W_FFN_OUT + (size_t)(L) * DM * DFF * 2, DFF, modl + 5 * DM, (LAST) ? args.out : (float*)nullptr, (LAST) ? 64 : 68, (LAST), (const float*)nullptr); } \
    if (!(LAST)) SEAM(PB + 9); \
    } while (0)

    LAYER(0, 0, 0, 0);
    LAYER(1, 1, 0, 0);
    LAYER(2, 2, 0, 0);
    LAYER(3, 0, 1, 1);
#undef IN
#undef SEAM
}

extern "C" void kernel_launch(void* const* d_in, const int* in_sizes, int n_in, void* d_out, int out_size, void* d_ws, size_t ws_size, hipStream_t stream) {
    static int grid = 0;
    if (grid == 0) {
        if (n_in != 24 || in_sizes[0] != NB * SEQ * DM || out_size != NB * SEQ * DM || ws_size < WS_END) {
            fprintf(stderr, "kernel_launch: shape/workspace mismatch: n_in %d in0 %d out %d ws %zu (need %zu); nothing launched\n", n_in, n_in > 0 ? in_sizes[0] : -1, out_size, ws_size, (size_t)WS_END); grid = -1; return; }
        int dev = 0, cus = 0, per_cu = 0;
        if (hipGetDevice(&dev) != hipSuccess || hipDeviceGetAttribute(&cus, hipDeviceAttributeMultiprocessorCount, dev) != hipSuccess) { fprintf(stderr, "kernel_launch: device query failed\n"); grid = -1; return; }
        if (hipFuncSetAttribute((const void*)mega_fwd, hipFuncAttributeMaxDynamicSharedMemorySize, LDS_BYTES) != hipSuccess) { fprintf(stderr, "kernel_launch: hipFuncSetAttribute failed\n"); grid = -1; return; }
        if (hipOccupancyMaxActiveBlocksPerMultiprocessor(&per_cu, (const void*)mega_fwd, NTHR, LDS_BYTES) != hipSuccess || per_cu < 1)
            fprintf(stderr, "kernel_launch: note: occupancy query reports %d workgroups per CU\n", per_cu);
        (void)hipGetLastError();
        grid = cus;
    }
    if (grid < 0) return;
    if (hipMemsetAsync((char*)d_ws + WS_CTL, 0, CTL_ZERO_BYTES, stream) != hipSuccess) { fprintf(stderr, "kernel_launch: memset failed\n"); return; }
    Args a{};
    for (int i = 0; i < 24; ++i) a.in[i] = (const float*)d_in[i];
    a.out = (float*)d_out; a.ws = (unsigned char*)d_ws;
#if MK_PER_PHASE
    for (int p = 0; p < NPHASE; ++p) {
        if (p == 6 || p == 36) continue;
        a.ph_lo = p; a.ph_hi = p + 1;
        hipLaunchKernelGGL(mega_fwd, dim3(grid), dim3(NTHR), LDS_BYTES, stream, a);
    }
#else
    a.ph_lo = 0; a.ph_hi = NPHASE;
    hipLaunchKernelGGL(mega_fwd, dim3(grid), dim3(NTHR), LDS_BYTES, stream, a);
#endif
    const hipError_t le = hipPeekAtLastError();
    if (le != hipSuccess) fprintf(stderr, "kernel_launch: launch failed: %s\n", hipGetErrorName(le));
}
```
